# Optimizing an MI355X kernel written in HIP

```python
import jax
import jax.numpy as jnp
from jax import lax
import numpy as np

D_MODEL = 2048
BATCH = 2
SEQ = 4096
DEPTH = 2

GRID_W = 64
CTX_LEN = 256

D_RWKV = 3 * D_MODEL // 8
D_POOL = D_MODEL // 4
D_ATT = 3 * D_MODEL // 8
D_MIX = D_RWKV + D_POOL + D_ATT

RWKV_HEAD_DIM = 64
RWKV_HEADS = D_RWKV // RWKV_HEAD_DIM
DECAY_RANK = 64
AAA_RANK = 64
GATE_RANK = 128
RWKV_GN_EPS = 64e-5

POOL_WINDOWS = (2, 4, 8, 16)
POOL_GROUPS = 4
POOL_GROUP_DIM = D_POOL // POOL_GROUPS

ATT_HEAD_DIM = 64
ATT_Q_HEADS = D_ATT // ATT_HEAD_DIM
ATT_KV_HEADS = ATT_Q_HEADS // 3
ATT_KV_DIM = ATT_KV_HEADS * ATT_HEAD_DIM
ATT_WINDOW = 128
ATT_BLOCK = 128
ROPE_BASE = 10000.0

FFN_HIDDEN = ((8 * D_MODEL + 3 * 256 - 1) // (3 * 256)) * 256
NORM_EPS = 1e-6

OFF_R = 0
OFF_K = D_RWKV
OFF_V = 2 * D_RWKV
OFF_WD = 3 * D_RWKV
OFF_AD = OFF_WD + 2 * DECAY_RANK
OFF_GD = OFF_AD + 2 * AAA_RANK
RWKV_COLS = OFF_GD + GATE_RANK
OFF_POOL = RWKV_COLS
OFF_AQ = OFF_POOL + D_POOL
OFF_AK = OFF_AQ + D_ATT
OFF_AV = OFF_AK + ATT_KV_DIM
D_IN = OFF_AV + ATT_KV_DIM

kernel_name = "hybrid_rwkv7_pool_swa_prefix_dit"


def rms_norm(x, g):
    xf = x.astype(jnp.float32)
    y = xf * lax.rsqrt(jnp.mean(xf * xf, axis=-1, keepdims=True) + NORM_EPS)
    return (y * g.astype(jnp.float32)).astype(x.dtype)


def swiglu(h, w_gu, w_down):
    gate, up = jnp.split(h @ w_gu, 2, axis=-1)
    return (jax.nn.silu(gate) * up) @ w_down


def centred_token_shift(z, mu):
    zp = jnp.pad(z, ((0, 0), (1, 1), (0, 0)))
    nb = 0.5 * (zp[:, :-2] + zp[:, 2:])
    return z + mu * (nb - z)


def rwkv_prepare(z, mu, w0, w_up, a0, a_up, g_up, k_k, k_a, r_k):
    B, T, _ = z.shape
    H, N = RWKV_HEADS, RWKV_HEAD_DIM
    z = centred_token_shift(z, mu)
    r = z[..., OFF_R:OFF_K].reshape(B, T, H, N)
    k = z[..., OFF_K:OFF_V]
    v = z[..., OFF_V:OFF_WD].reshape(B, T, H, N)
    wd = z[..., OFF_WD:OFF_AD].reshape(B, T, 2, DECAY_RANK)
    ad = z[..., OFF_AD:OFF_GD].reshape(B, T, 2, AAA_RANK)
    gd = z[..., OFF_GD:RWKV_COLS]
    w_log = -jax.nn.softplus(-(w0 + jnp.einsum('btdr,drc->btdc', jnp.tanh(wd), w_up))) - 0.5
    decay = jnp.exp(-jnp.exp(w_log.astype(jnp.float32))).reshape(B, T, 2, H, N)
    a = jax.nn.sigmoid(a0 + jnp.einsum('btdr,drc->btdc', ad, a_up))
    g = jnp.einsum('btr,rc->btc', jax.nn.sigmoid(gd), g_up)
    kk = (k * k_k).reshape(B, T, H, N).astype(jnp.float32)
    kk = kk / jnp.maximum(jnp.sqrt(jnp.sum(kk * kk, axis=-1, keepdims=True)), 1e-12)
    k_dir = (k[:, :, None, :] * (1.0 + (a - 1.0) * k_a)).reshape(B, T, 2, H, N)
    a = a.reshape(B, T, 2, H, N)
    a_vec = -kk
    b_dir = kk[:, :, None] * a
    bonus = jnp.sum(jnp.sum(r[:, :, None] * k_dir * r_k, axis=-1, keepdims=True) * v[:, :, None], axis=2)
    return r, k_dir, v, decay, a_vec, b_dir, g, bonus


def rwkv_scan(S0, r, decay, k, v, a_vec, b_vec, reverse):
    tm = lambda t: None if t is None else jnp.moveaxis(t.astype(jnp.float32), 1, 0)

    def step(S, inp):
        r_t, w_t, k_t, v_t, a_t, b_t = inp
        sa = jnp.einsum('bhij,bhj->bhi', S, a_t)
        S = S * w_t[:, :, None, :] + sa[..., None] * b_t[:, :, None, :] + v_t[..., None] * k_t[:, :, None, :]
        y = None if r_t is None else jnp.einsum('bhij,bhj->bhi', S, r_t)
        return S, y

    S, ys = lax.scan(step, S0, (tm(r), tm(decay), tm(k), tm(v), tm(a_vec), tm(b_vec)), reverse=reverse)
    return S, (None if r is None else jnp.moveaxis(ys, 0, 1))


def rwkv_readout(y, bonus, g, ln_g, ln_b):
    B, T, H, N = y.shape
    mu = jnp.mean(y, axis=-1, keepdims=True)
    var = jnp.mean(jnp.square(y - mu), axis=-1, keepdims=True)
    yn = ((y - mu) * lax.rsqrt(var + RWKV_GN_EPS)).reshape(B, T, H * N)
    yn = yn * ln_g + ln_b
    return ((yn + bonus.reshape(B, T, H * N)) * g).astype(g.dtype)


def rwkv_mix(prep, prep_c, ln_g, ln_b, emit_ctx):
    r, kd, v, decay, a_vec, b_dir, g, bonus = prep
    rc, kdc, vc, decayc, a_vec_c, b_dirc, gc, bonusc = prep_c
    B = r.shape[0]
    S0 = jnp.zeros((B, RWKV_HEADS, RWKV_HEAD_DIM, RWKV_HEAD_DIM), jnp.float32)
    y_lat = 0.0
    y_ctx = 0.0
    for d in range(2):
        rev = d == 1
        S_c, yc = rwkv_scan(S0, rc if emit_ctx else None, decayc[:, :, d], kdc[:, :, d], vc,
                            a_vec_c, b_dirc[:, :, d], rev)
        _, yl = rwkv_scan(S_c, r, decay[:, :, d], kd[:, :, d], v, a_vec, b_dir[:, :, d], rev)
        y_lat = y_lat + yl
        if emit_ctx:
            y_ctx = y_ctx + yc
    out = rwkv_readout(y_lat, bonus, g, ln_g, ln_b)
    out_c = rwkv_readout(y_ctx, bonusc, gc, ln_g, ln_b) if emit_ctx else None
    return out, out_c


def multiscale_pool(p, pool_w, pool_scale):
    B, T, _ = p.shape
    pf = p.astype(jnp.float32)
    cs = jnp.concatenate([jnp.zeros((B, 1, D_POOL), jnp.float32), jnp.cumsum(pf, axis=1)], axis=1)
    t = jnp.arange(T)
    means = []
    for gi, w in enumerate(POOL_WINDOWS):
        lo = jnp.clip(t - w // 2, 0, T)
        hi = jnp.clip(t - w // 2 + w, 0, T)
        csg = cs[..., gi * POOL_GROUP_DIM:(gi + 1) * POOL_GROUP_DIM]
        cnt = (hi - lo).astype(jnp.float32)[None, :, None]
        means.append((csg[:, hi] - csg[:, lo]) / cnt)
    mean = jnp.stack(means, axis=2)
    y = mean - pf.reshape(B, T, POOL_GROUPS, POOL_GROUP_DIM)
    y = jnp.einsum('btgc,gcd->btgd', y, pool_w.astype(jnp.float32)).reshape(B, T, D_POOL)
    return (y * pool_scale).astype(p.dtype)


def axial_rope_tables(T):
    rows = T // GRID_W
    row = jnp.repeat(jnp.arange(rows), GRID_W).astype(jnp.float32)
    col = jnp.tile(jnp.arange(GRID_W), rows).astype(jnp.float32)
    n_freq = ATT_HEAD_DIM // 4
    inv = ROPE_BASE ** (-jnp.arange(n_freq, dtype=jnp.float32) / n_freq)
    ang_r = row[:, None] * inv
    ang_c = col[:, None] * inv
    ang = jnp.concatenate([ang_r, ang_r, ang_c, ang_c], axis=-1)
    return jnp.cos(ang), jnp.sin(ang)


def apply_axial_rope(x, cos, sin):
    x1, x2, x3, x4 = jnp.split(x, 4, axis=-1)
    rot = jnp.concatenate([-x2, x1, -x4, x3], axis=-1)
    return (x * cos[:, None, :] + rot * sin[:, None, :]).astype(x.dtype)


def window_attention(q, k, v, kc, vc, sink):
    B, T, Hq, Dh = q.shape
    Hkv = k.shape[2]
    G = Hq // Hkv
    nb = T // ATT_BLOCK
    scale = Dh ** -0.5
    qb = q.reshape(B, nb, ATT_BLOCK, Hkv, G, Dh)
    pad = lambda t: jnp.pad(t, ((0, 0), (ATT_BLOCK, ATT_BLOCK), (0, 0), (0, 0))).reshape(B, nb + 2, ATT_BLOCK, Hkv, Dh)
    band = lambda t: jnp.concatenate([t[:, :-2], t[:, 1:-1], t[:, 2:]], axis=2)
    kw, vw = band(pad(k)), band(pad(v))
    s_loc = jnp.einsum('bnqhgd,bnkhd->bnhgqk', qb, kw).astype(jnp.float32) * scale
    qi = jnp.arange(ATT_BLOCK)[:, None]
    kj = jnp.arange(3 * ATT_BLOCK)[None, :]
    rel = kj - ATT_BLOCK - qi
    kpos = jnp.arange(nb)[:, None, None] * ATT_BLOCK - ATT_BLOCK + kj[None]
    valid = (jnp.abs(rel) <= ATT_WINDOW)[None] & (kpos >= 0) & (kpos < T)
    s_loc = jnp.where(valid[None, :, None, None], s_loc, -1e30)
    s_ctx = jnp.einsum('bnqhgd,bchd->bnhgqc', qb, kc).astype(jnp.float32) * scale
    s_sink = jnp.broadcast_to(sink.astype(jnp.float32).reshape(Hkv, G)[None, None, :, :, None, None],
                              s_loc.shape[:-1] + (1,))
    p = jax.nn.softmax(jnp.concatenate([s_loc, s_ctx, s_sink], axis=-1), axis=-1)
    n_loc = 3 * ATT_BLOCK
    n_ctx = kc.shape[1]
    p_loc = p[..., :n_loc].astype(v.dtype)
    p_ctx = p[..., n_loc:n_loc + n_ctx].astype(v.dtype)
    o = jnp.einsum('bnhgqk,bnkhd->bnqhgd', p_loc, vw) + jnp.einsum('bnhgqc,bchd->bnqhgd', p_ctx, vc)
    return o.reshape(B, T, Hq * Dh)


def context_attention(qc, kc, vc, sink):
    B, C, Hq, Dh = qc.shape
    Hkv = kc.shape[2]
    G = Hq // Hkv
    qg = qc.reshape(B, C, Hkv, G, Dh)
    s = jnp.einsum('bqhgd,bkhd->bhgqk', qg, kc).astype(jnp.float32) * (Dh ** -0.5)
    s_sink = jnp.broadcast_to(sink.astype(jnp.float32).reshape(Hkv, G)[None, :, :, None, None], s.shape[:-1] + (1,))
    p = jax.nn.softmax(jnp.concatenate([s, s_sink], axis=-1), axis=-1)[..., :C].astype(vc.dtype)
    o = jnp.einsum('bhgqk,bkhd->bqhgd', p, vc)
    return o.reshape(B, C, Hq * Dh)


def setup_inputs(seed: int = 0) -> dict:
    key = jax.random.key(seed)
    ks = jax.random.split(key, 32)
    L, D = DEPTH, D_MODEL
    nrm = lambda k, shape, s: jax.random.normal(k, shape, jnp.float32) * s
    return {
        "x": nrm(ks[0], (BATCH, SEQ, D), 1.0),
        "c": nrm(ks[1], (BATCH, D), 1.0),
        "ctx": nrm(ks[2], (BATCH, CTX_LEN, D), 1.0),
        "c_ctx": nrm(ks[3], (D,), 1.0),
        "ada_w": nrm(ks[4], (L, D, 6 * D), 0.5 * D ** -0.5),
        "ada_b": nrm(ks[5], (L, 6 * D), 0.02),
        "norm_mix_g": 1.0 + nrm(ks[6], (L, D), 0.05),
        "norm_ffn_g": 1.0 + nrm(ks[7], (L, D), 0.05),
        "w_in": nrm(ks[8], (L, D, D_IN), D ** -0.5),
        "rwkv_mu": jax.random.uniform(ks[9], (L, RWKV_COLS), jnp.float32, 0.2, 0.8),
        "rwkv_w0": jax.random.uniform(ks[10], (L, 2, D_RWKV), jnp.float32, -6.0, -1.0),
        "rwkv_w_up": nrm(ks[11], (L, 2, DECAY_RANK, D_RWKV), 0.1 * DECAY_RANK ** -0.5),
        "rwkv_a0": nrm(ks[12], (L, 2, D_RWKV), 0.3),
        "rwkv_a_up": nrm(ks[13], (L, 2, AAA_RANK, D_RWKV), 0.3 * AAA_RANK ** -0.5),
        "rwkv_g_up": nrm(ks[14], (L, GATE_RANK, D_RWKV), GATE_RANK ** -0.5),
        "rwkv_k_k": 0.85 + nrm(ks[15], (L, D_RWKV), 0.05),
        "rwkv_k_a": 1.0 + nrm(ks[16], (L, D_RWKV), 0.05),
        "rwkv_r_k": nrm(ks[17], (L, RWKV_HEADS, RWKV_HEAD_DIM), 0.1),
        "rwkv_ln_g": 1.0 + nrm(ks[18], (L, D_RWKV), 0.05),
        "rwkv_ln_b": nrm(ks[19], (L, D_RWKV), 0.02),
        "pool_w": nrm(ks[20], (L, POOL_GROUPS, POOL_GROUP_DIM, POOL_GROUP_DIM), POOL_GROUP_DIM ** -0.5),
        "pool_scale": 1.0 + nrm(ks[21], (L, D_POOL), 0.1),
        "attn_sink": nrm(ks[22], (L, ATT_Q_HEADS), 1.0),
        "w_out": nrm(ks[23], (L, D_MIX, D), D_MIX ** -0.5),
        "ffn_w_gu": nrm(ks[24], (L, D, 2 * FFN_HIDDEN), D ** -0.5),
        "ffn_w_down": nrm(ks[25], (L, FFN_HIDDEN, D), FFN_HIDDEN ** -0.5),
        "final_norm_g": 1.0 + nrm(ks[26], (D,), 0.05),
    }


def reference(x, c, ctx, c_ctx, ada_w, ada_b, norm_mix_g, norm_ffn_g, w_in, rwkv_mu, rwkv_w0, rwkv_w_up,
              rwkv_a0, rwkv_a_up, rwkv_g_up, rwkv_k_k, rwkv_k_a, rwkv_r_k, rwkv_ln_g, rwkv_ln_b, pool_w,
              pool_scale, attn_sink, w_out, ffn_w_gu, ffn_w_down, final_norm_g):
    B, T, _ = x.shape
    C = ctx.shape[1]
    cos, sin = axial_rope_tables(T)
    xc = ctx
    for l in range(DEPTH):
        last = l == DEPTH - 1
        mod = (jax.nn.silu(c) @ ada_w[l] + ada_b[l])[:, None, :]
        mod_c = jax.nn.silu(c_ctx) @ ada_w[l] + ada_b[l]
        sh1, sc1, gt1, sh2, sc2, gt2 = jnp.split(mod, 6, axis=-1)
        csh1, csc1, cgt1, csh2, csc2, cgt2 = jnp.split(mod_c, 6, axis=-1)

        h = rms_norm(x, norm_mix_g[l]) * (1.0 + sc1) + sh1
        hc = rms_norm(xc, norm_mix_g[l]) * (1.0 + csc1) + csh1
        z = h @ w_in[l]
        zc = hc @ w_in[l]

        rw = (rwkv_mu[l], rwkv_w0[l], rwkv_w_up[l], rwkv_a0[l], rwkv_a_up[l], rwkv_g_up[l],
              rwkv_k_k[l], rwkv_k_a[l], rwkv_r_k[l])
        prep = rwkv_prepare(z[..., :RWKV_COLS], *rw)
        prep_c = rwkv_prepare(zc[..., :RWKV_COLS], *rw)
        y_r, yc_r = rwkv_mix(prep, prep_c, rwkv_ln_g[l], rwkv_ln_b[l], not last)

        y_p = multiscale_pool(z[..., OFF_POOL:OFF_AQ], pool_w[l], pool_scale[l])

        q = apply_axial_rope(z[..., OFF_AQ:OFF_AK].reshape(B, T, ATT_Q_HEADS, ATT_HEAD_DIM), cos, sin)
        k = apply_axial_rope(z[..., OFF_AK:OFF_AV].reshape(B, T, ATT_KV_HEADS, ATT_HEAD_DIM), cos, sin)
        v = z[..., OFF_AV:D_IN].reshape(B, T, ATT_KV_HEADS, ATT_HEAD_DIM)
        kc = zc[..., OFF_AK:OFF_AV].reshape(B, C, ATT_KV_HEADS, ATT_HEAD_DIM)
        vc = zc[..., OFF_AV:D_IN].reshape(B, C, ATT_KV_HEADS, ATT_HEAD_DIM)
        y_a = window_attention(q, k, v, kc, vc, attn_sink[l])

        y = jnp.concatenate([y_r, y_p.astype(y_r.dtype), y_a.astype(y_r.dtype)], axis=-1)
        x = x + gt1 * (y @ w_out[l])
        h2 = rms_norm(x, norm_ffn_g[l]) * (1.0 + sc2) + sh2
        x = x + gt2 * swiglu(h2, ffn_w_gu[l], ffn_w_down[l])

        if not last:
            yc_p = multiscale_pool(zc[..., OFF_POOL:OFF_AQ], pool_w[l], pool_scale[l])
            qc = zc[..., OFF_AQ:OFF_AK].reshape(B, C, ATT_Q_HEADS, ATT_HEAD_DIM)
            yc_a = context_attention(qc, kc, vc, attn_sink[l])
            ycat = jnp.concatenate([yc_r, yc_p.astype(yc_r.dtype), yc_a.astype(yc_r.dtype)], axis=-1)
            xc = xc + cgt1 * (ycat @ w_out[l])
            hc2 = rms_norm(xc, norm_ffn_g[l]) * (1.0 + csc2) + csh2
            xc = xc + cgt2 * swiglu(hc2, ffn_w_gu[l], ffn_w_down[l])
    return rms_norm(x, final_norm_g)
```

```cpp
#include <hip/hip_runtime.h>
#include <hip/hip_cooperative_groups.h>
#include <cstdint>
#include <cstdio>
namespace cg = cooperative_groups;

typedef unsigned short bf16_t;
typedef short bf16x8 __attribute__((ext_vector_type(8)));
typedef float f32x4 __attribute__((ext_vector_type(4)));

constexpr int D = 2048, T = 4096, CTX = 256, NLAT = 8192, NCTXR = 512, NTOK = 8704;
constexpr int DIN = 4480, ZC = 3200, FH = 5632;
constexpr int DR = 768;
constexpr int VTS = T + CTX;
constexpr int NT = 256;
constexpr int NTR = 512;
constexpr int DINP = 4608;
constexpr int LDS_BYTES = 131072 + 256;

struct P {
  const float *x, *c, *ctx, *c_ctx, *ada_w, *ada_b, *nmg, *nfg, *w_in, *mu, *w0, *w_up, *a0, *a_up, *g_up, *k_k, *k_a, *r_k,
      *ln_g, *ln_b, *pool_w, *pool_scale, *sink, *w_out, *w_gu, *w_down, *fng;
  float* out;
  bf16_t *wt_in, *wt_out, *wt_gu, *wt_down;
  float* X; bf16_t* HB; float* Z; bf16_t *QB, *KB, *VT; float *SOPS, *SHR, *GB, *BON, *YB, *MOD, *MODP, *ROPE; bf16_t* HID; unsigned* bar; bf16_t* WLR; bf16_t* PWF;
};

__device__ __forceinline__ int otid() { int t = threadIdx.x & 255; asm volatile("" : "+v"(t)); return t; }
__device__ __forceinline__ int obid() { int t = blockIdx.x * 2 + __builtin_amdgcn_readfirstlane(threadIdx.x >> 8); asm volatile("" : "+s"(t)); return t; }
__device__ __forceinline__ int rtid() { int t = threadIdx.x; asm volatile("" : "+v"(t)); return t; }
__device__ __forceinline__ int rbid() { int t = blockIdx.x; asm volatile("" : "+s"(t)); return t; }
#define VG ((int)(gridDim.x * 2))
#define UNIFORM_TASKS(it, n, first, stride, NBAR, CALL) for (int _b0 = 0; _b0 < (n); _b0 += (stride)) { const int it = _b0 + (first); \
    if (it < (n)) { CALL; } else { for (int _k = 0; _k < (NBAR); ++_k) __syncthreads(); } }
__device__ __forceinline__ unsigned pk_bf16(float lo, float hi) {
  unsigned r; asm("v_cvt_pk_bf16_f32 %0, %1, %2" : "=v"(r) : "v"(lo), "v"(hi)); return r;
}
__device__ __forceinline__ bf16_t f2bf(float f) { return (bf16_t)(pk_bf16(f, 0.f) & 0xffffu); }
__device__ __forceinline__ float wave_sum(float v) {
#pragma unroll
  for (int o = 32; o >= 1; o >>= 1) v += __shfl_xor(v, o);
  return v;
}
template <int CTRL> __device__ __forceinline__ float dpp_add(float x) {
  int y = __builtin_amdgcn_update_dpp(0, __float_as_int(x), CTRL, 0xF, 0xF, false);
  return x + __int_as_float(y);
}
__device__ __forceinline__ float reduce16(float x) {
  x = dpp_add<0x128>(x);
  x = dpp_add<0x124>(x);
  x = dpp_add<0x122>(x);
  x = dpp_add<0x121>(x);
  return x;
}
__device__ __forceinline__ float sigmoidf_(float x) { return __builtin_amdgcn_rcpf(1.f + __expf(-x)); }
__device__ __forceinline__ size_t zidx(int row, int col) { return ((((size_t)(row >> 4) * (ZC / 16) + (col >> 4)) * 16 + (row & 15)) << 4) + (col & 15); }
__device__ __forceinline__ void kv_tile_of_row(int row, int& s, int& tile, int& u) {
  if (row < NLAT) { s = row >> 12; const int t = row & (T - 1); tile = t >> 5; u = t & 31; }
  else { const int rc = row - NLAT; s = rc >> 8; tile = 128 + ((rc & 255) >> 5); u = rc & 31; }
}
__device__ __forceinline__ int mod_vec(int row) { return row < NLAT ? (row >> 12) : 2; }
__device__ __forceinline__ const float* resid_in(const P& p, int row) {
  return row < NLAT ? p.x + (size_t)row * D : p.ctx + (size_t)(row - NLAT) * D;
}

struct HalfBar { volatile __attribute__((address_space(3))) unsigned* cnt; unsigned gen; };
template <bool SOFT> __device__ __forceinline__ void vbar(HalfBar& hb) {
  if (!SOFT) { __syncthreads(); return; }
  asm volatile("s_waitcnt lgkmcnt(0)" ::: "memory");
  hb.gen += 4u;
  if ((threadIdx.x & 63) == 0) {
    __hip_atomic_fetch_add((__attribute__((address_space(3))) unsigned*)hb.cnt, 1u, __ATOMIC_RELEASE, __HIP_MEMORY_SCOPE_WORKGROUP);
    while (__hip_atomic_load((__attribute__((address_space(3))) unsigned*)hb.cnt, __ATOMIC_ACQUIRE, __HIP_MEMORY_SCOPE_WORKGROUP) < hb.gen) __builtin_amdgcn_s_sleep(1);
  }
  asm volatile("s_waitcnt lgkmcnt(0)" ::: "memory");
}

template <bool SOFT>
__device__ void convert_tile(const float* __restrict__ W, int K, int N, bf16_t* __restrict__ Bt, int gu, int tile, float* s, HalfBar& hb) {
  const int tid = otid();
  const int nkb = K >> 6;
  const int kb = tile % nkb, nb = tile / nkb;
#pragma unroll
  for (int i = 0; i < 4; ++i) {
    int idx = tid + NT * i; int kk = idx >> 4, n4 = idx & 15;
    const f32x4 v4 = __builtin_nontemporal_load((const f32x4*)(W + (size_t)(kb * 64 + kk) * N + nb * 64 + n4 * 4));
    float4 v; v.x = v4[0]; v.y = v4[1]; v.z = v4[2]; v.w = v4[3];
    s[(n4 * 4 + 0) * 65 + kk] = v.x; s[(n4 * 4 + 1) * 65 + kk] = v.y; s[(n4 * 4 + 2) * 65 + kk] = v.z; s[(n4 * 4 + 3) * 65 + kk] = v.w;
  }
  vbar<SOFT>(hb);
#pragma unroll
  for (int i = 0; i < 2; ++i) {
    int idx = tid + NT * i; int n = idx >> 3, k8 = idx & 7;
    const float* sp = s + n * 65 + k8 * 8;
    uint4 o; o.x = pk_bf16(sp[0], sp[1]); o.y = pk_bf16(sp[2], sp[3]); o.z = pk_bf16(sp[4], sp[5]); o.w = pk_bf16(sp[6], sp[7]);
    int nn = nb * 64 + n;
    if (gu) { if (nn < FH) nn = (nn >> 4) * 32 + (nn & 15); else { int h = nn - FH; nn = (h >> 4) * 32 + 16 + (h & 15); } }
    *(uint4*)(Bt + (size_t)nn * K + kb * 64 + k8 * 8) = o;
  }
  vbar<SOFT>(hb);
}

__device__ void phase_a(const P& p, char* lds) {
  float* s = (float*)lds;
  HalfBar hb0{nullptr, 0u};
  const int tid = otid();
  UNIFORM_TASKS(it, 32 * 70, obid(), VG, 2, convert_tile<false>(p.w_in, D, DIN, p.wt_in, 0, it, s, hb0))
  for (int b0 = 0; b0 < 2 * 12 * 32; b0 += VG) {
    const int it = b0 + obid();
    if (it >= 2 * 12 * 32) { __syncthreads(); __syncthreads(); continue; }
    int l = it / 384, r = it % 384, cb = r / 32, ks = r % 32;
    if (tid < 192) {
      int v = tid >> 6, k = ks * 64 + (tid & 63);
      float cv = v == 0 ? p.c[k] : (v == 1 ? p.c[D + k] : p.c_ctx[k]);
      s[tid] = cv * sigmoidf_(cv);
    }
    __syncthreads();
    float4 a0 = {0, 0, 0, 0}, a1 = a0, a2 = a0;
    const float* wp = p.ada_w + ((size_t)l * D + ks * 64) * (6 * D) + cb * 1024 + tid * 4;
#pragma unroll 8
    for (int kk = 0; kk < 64; ++kk) {
      const f32x4 w4 = __builtin_nontemporal_load((const f32x4*)(wp + (size_t)kk * (6 * D)));
      float4 w; w.x = w4[0]; w.y = w4[1]; w.z = w4[2]; w.w = w4[3];
      float s0 = s[kk], s1 = s[64 + kk], s2 = s[128 + kk];
      a0.x += s0 * w.x; a0.y += s0 * w.y; a0.z += s0 * w.z; a0.w += s0 * w.w;
      a1.x += s1 * w.x; a1.y += s1 * w.y; a1.z += s1 * w.z; a1.w += s1 * w.w;
      a2.x += s2 * w.x; a2.y += s2 * w.y; a2.z += s2 * w.z; a2.w += s2 * w.w;
    }
    float* o = p.MODP + ((size_t)(ks * 2 + l) * 3) * (6 * D) + cb * 1024 + tid * 4;
    *(float4*)(o) = a0; *(float4*)(o + 6 * D) = a1; *(float4*)(o + 12 * D) = a2;
    __syncthreads();
  }
  for (int idx = obid() * NT + tid; idx < 2 * DR * 48; idx += VG * NT) {
    const int l = idx / (DR * 48), rem = idx % (DR * 48), c = rem / 48, k0 = (rem % 48) * 8;
    const float* srcw = k0 < 128 ? p.w_up : (k0 < 256 ? p.a_up : p.g_up);
    const int kb = k0 < 128 ? k0 : (k0 < 256 ? k0 - 128 : k0 - 256);
    float v[8];
#pragma unroll
    for (int j = 0; j < 8; ++j) v[j] = srcw[((size_t)l * 128 + kb + j) * DR + c];
    uint4 o; o.x = pk_bf16(v[0], v[1]); o.y = pk_bf16(v[2], v[3]); o.z = pk_bf16(v[4], v[5]); o.w = pk_bf16(v[6], v[7]);
    *(uint4*)(p.WLR + ((((size_t)(l * 12 + (c >> 6)) * 4 + ((c >> 4) & 3)) * 12 + (k0 >> 5)) * 64 + ((k0 >> 3) & 3) * 16 + (c & 15)) * 8) = o;
  }
  for (int idx = obid() * NT + tid; idx < 2 * 4 * 8 * 4 * 64; idx += VG * NT) {
    const int ln = idx & 63, ks = (idx >> 6) & 3, nt = (idx >> 8) & 7, lg = idx >> 11;
    const int d = nt * 16 + (ln & 15), c0 = ks * 32 + (ln >> 4) * 8;
    float v[8];
#pragma unroll
    for (int j = 0; j < 8; ++j) v[j] = p.pool_w[((size_t)lg * 128 + c0 + j) * 128 + d];
    uint4 o; o.x = pk_bf16(v[0], v[1]); o.y = pk_bf16(v[2], v[3]); o.z = pk_bf16(v[4], v[5]); o.w = pk_bf16(v[6], v[7]);
    *(uint4*)(p.PWF + (size_t)idx * 8) = o;
  }
  if (obid() == VG - 1) {
    for (int e = tid; e < 1024; e += NT) {
      int pos = e >> 4, i = e & 15;
      float inv = (float)exp2(-(double)i / 16.0 * 13.287712379549449);
      float angf = (float)pos * inv;
      double a = (double)angf;
      double n = rint(a * 0.6366197723675814);
      double r = a - n * 1.5707963267948966;
      double r2 = r * r;
      double sn = r * (1.0 + r2 * (-1.0 / 6 + r2 * (1.0 / 120 + r2 * (-1.0 / 5040 + r2 * (1.0 / 362880 + r2 * (-1.0 / 39916800 + r2 * (1.0 / 6227020800.0)))))));
      double cs = 1.0 + r2 * (-0.5 + r2 * (1.0 / 24 + r2 * (-1.0 / 720 + r2 * (1.0 / 40320 + r2 * (-1.0 / 3628800 + r2 * (1.0 / 479001600.0 + r2 * (-1.0 / 87178291200.0)))))));
      int qd = ((int)n) & 3;
      double c2 = qd == 0 ? cs : (qd == 1 ? -sn : (qd == 2 ? -cs : sn));
      double s2 = qd == 0 ? sn : (qd == 1 ? cs : (qd == 2 ? -sn : -cs));
      p.ROPE[e] = (float)c2; p.ROPE[1024 + e] = (float)s2;
    }
  }
}

__device__ void phase_b(const P& p) {
  for (int idx = obid() * NT + otid(); idx < 2 * 3 * 6 * D; idx += VG * NT) {
    int n = idx % (6 * D), lv = idx / (6 * D), l = lv / 3, v = lv % 3;
    float sum = p.ada_b[l * 6 * D + n];
#pragma unroll 8
    for (int ks = 0; ks < 32; ++ks) sum += p.MODP[((size_t)(ks * 2 + l) * 3 + v) * (6 * D) + n];
    p.MOD[idx] = sum;
  }
}

__device__ void norm_phase(const P& p, int layer, int which, int nrows) {
  const int lane = otid() & 63, wave = otid() >> 6;
  const float* g = (which ? p.nfg : p.nmg) + layer * D;
  const int NW = VG * 4, gw = obid() * 4 + wave;
  const int nlat = min(nrows, NLAT), rpw = (nlat + NW - 1) / NW;
  const int nctx_w = nrows > NLAT ? (nrows - NLAT - gw + NW - 1) / NW : 0;
  float4 mult[8], shv[8]; int cv = -1;
  for (int k = 0; k < rpw + (nctx_w > 0 ? nctx_w : 0); ++k) {
    int row;
    if (k < rpw) { row = gw * rpw + k; if (row >= nlat) continue; }
    else { row = NLAT + gw + (k - rpw) * NW; if (row >= nrows) continue; }
    const int mv = mod_vec(row);
    if (mv != cv) {
      cv = mv;
      const float* md = p.MOD + ((size_t)(layer * 3 + mv) * 6 + (which ? 3 : 0)) * D;
#pragma unroll
      for (int i = 0; i < 8; ++i) {
        const int col = i * 256 + lane * 4;
        const float4 gg = *(const float4*)(g + col), sh = *(const float4*)(md + col), sc = *(const float4*)(md + D + col);
        mult[i].x = gg.x * (1.f + sc.x); mult[i].y = gg.y * (1.f + sc.y); mult[i].z = gg.z * (1.f + sc.z); mult[i].w = gg.w * (1.f + sc.w);
        shv[i] = sh;
      }
    }
    const float* src = (layer == 0 && which == 0) ? resid_in(p, row) : p.X + (size_t)row * D;
    float4 v[8]; float ss = 0.f;
    const bool foldO = (layer == 0 && which == 1 && row >= NLAT), foldD = (layer == 1 && which == 0 && row >= NLAT);
    if (foldO) src = resid_in(p, row);
#pragma unroll
    for (int i = 0; i < 8; ++i) {
      const int col = i * 256 + lane * 4;
      v[i] = *(const float4*)(src + col);
      if (foldO || foldD) {
        const float* sl = p.Z + (foldD ? (size_t)8 * NCTXR * D : 0) + (size_t)(row - NLAT) * D + col;
        const int ns = foldD ? 11 : 8;
        float4 a = *(const float4*)(sl);
        for (int s = 1; s < ns; ++s) { const float4 b = *(const float4*)(sl + (size_t)s * NCTXR * D); a.x += b.x; a.y += b.y; a.z += b.z; a.w += b.w; }
        const float4 gt = *(const float4*)(p.MOD + ((size_t)(0 * 3 + 2) * 6 + (foldO ? 2 : 5)) * D + col);
        v[i].x += gt.x * a.x; v[i].y += gt.y * a.y; v[i].z += gt.z * a.z; v[i].w += gt.w * a.w;
        if (foldO) *(float4*)(p.X + (size_t)row * D + col) = v[i];
      }
      ss += v[i].x * v[i].x + v[i].y * v[i].y + v[i].z * v[i].z + v[i].w * v[i].w;
    }
    ss = wave_sum(ss);
    const float rinv = rsqrtf(ss * (1.f / D) + 1e-6f);
#pragma unroll
    for (int i = 0; i < 8; ++i) {
      const int col = i * 256 + lane * 4;
      const float y0 = v[i].x * rinv * mult[i].x + shv[i].x, y1 = v[i].y * rinv * mult[i].y + shv[i].y;
      const float y2 = v[i].z * rinv * mult[i].z + shv[i].z, y3 = v[i].w * rinv * mult[i].w + shv[i].w;
      uint2 o; o.x = pk_bf16(y0, y1); o.y = pk_bf16(y2, y3);
      *(uint2*)(p.HB + (size_t)row * D + col) = o;
    }
  }
}

__device__ void final_phase(const P& p) {
  const int lane = otid() & 63, wave = otid() >> 6;
  float4 gf[8];
#pragma unroll
  for (int i = 0; i < 8; ++i) gf[i] = *(const float4*)(p.fng + i * 256 + lane * 4);
  for (int row = obid() * 4 + wave; row < NLAT; row += VG * 4) {
    const float* src = p.X + (size_t)row * D;
    float4 v[8]; float ss = 0.f;
#pragma unroll
    for (int i = 0; i < 8; ++i) { v[i] = *(const float4*)(src + i * 256 + lane * 4); ss += v[i].x * v[i].x + v[i].y * v[i].y + v[i].z * v[i].z + v[i].w * v[i].w; }
    ss = wave_sum(ss);
    float rinv = rsqrtf(ss * (1.f / D) + 1e-6f);
#pragma unroll
    for (int i = 0; i < 8; ++i) {
      int col = i * 256 + lane * 4;
      const float4 gg = gf[i];
      float4 o = {v[i].x * rinv * gg.x, v[i].y * rinv * gg.y, v[i].z * rinv * gg.z, v[i].w * rinv * gg.w};
      *(float4*)(p.out + (size_t)row * D + col) = o;
    }
  }
}

enum { EPI_IN = 0, EPI_OUT = 1, EPI_GU = 2, EPI_DOWN = 3 };
namespace g8 {
constexpr int BM = 256, BK = 64, HALF = 128, HTB = HALF * BK * 2, NXCD = 8, WGM = 4;
__device__ __forceinline__ int lds_byte(int r, int c) { const int st = (r >> 4) * 2 + (c >> 5), rr = r & 15, cc = c & 31, ob = rr * 64 + cc * 2; return st * 1024 + (ob ^ (((ob >> 9) & 1) << 5)); }
__device__ __forceinline__ void stage_rc(int b, int& R, int& C) { const int st = b / 1024, sb = b % 1024, swz = sb ^ (((sb >> 9) & 1) << 5); R = (st >> 1) * 16 + swz / 64; C = (st & 1) * 32 + (swz % 64) / 2; }
}

template <int EPI>
__device__ __forceinline__ void epi8(const P& p, int layer, const f32x4 (&acc)[2][2][4][2], int brow, int bcol, int wr, int wc, int fr, int fq) {
#pragma unroll
  for (int ai = 0; ai < 2; ++ai)
#pragma unroll
    for (int bj = 0; bj < 2; ++bj) {
      const int cb = (bcol >> 7) + bj;
      const int col = bcol + bj * 128 + wc * 32 + fq * 4;
      const int row0 = brow + ai * 128 + wr * 64 + fr;
      if (EPI == EPI_IN) {
        if (cb < 25) {
#pragma unroll
          for (int m = 0; m < 4; ++m) {
            float* zp = p.Z + zidx(row0 + m * 16, col);
            *(f32x4*)(zp) = acc[ai][bj][m][0]; *(f32x4*)(zp + 256) = acc[ai][bj][m][1];
          }
        } else if (cb < 33) {
          const bool isq = cb < 31;
          const float scl = isq ? 0.125f : 1.0f;
          bf16_t* dst = isq ? p.QB : p.KB;
          const int ld = isq ? DR : 256;
          const int cc = col - (isq ? 3200 : 3968);
          const int second = wc & 1;
#pragma unroll
          for (int m = 0; m < 4; ++m) {
            const int row = row0 + m * 16;
            f32x4 c1 = {1.f, 1.f, 1.f, 1.f}, s1 = {0.f, 0.f, 0.f, 0.f};
            if (row < NLAT) {
              const int t = row & (T - 1), pos = second ? (t & 63) : (t >> 6);
              c1 = *(const f32x4*)(p.ROPE + pos * 16 + fq * 4); s1 = *(const f32x4*)(p.ROPE + 1024 + pos * 16 + fq * 4);
            }
            const f32x4 x0 = acc[ai][bj][m][0], x1 = acc[ai][bj][m][1];
            const f32x4 o0 = (x0 * c1 - x1 * s1) * scl, o1 = (x1 * c1 + x0 * s1) * scl;
            uint2 w0, w1;
            w0.x = pk_bf16(o0[0], o0[1]); w0.y = pk_bf16(o0[2], o0[3]);
            w1.x = pk_bf16(o1[0], o1[1]); w1.y = pk_bf16(o1[2], o1[3]);
            if (isq) {
              bf16_t* dp = dst + (size_t)row * ld + cc;
              *(uint2*)(dp) = w0; *(uint2*)(dp + 16) = w1;
            } else {
              int s, tile, u; kv_tile_of_row(row, s, tile, u);
              const int hk = cc >> 6, d0 = cc & 63;
              const int kfr = (u >> 3) * 4 + (u & 3), kk = (u >> 2) & 1;
              bf16_t* kb = p.KB + ((size_t)(((s * 4 + hk) * 136 + tile) * 4 + kk * 2 + (d0 >> 5)) * 64 + kfr) * 8;
              *(uint2*)(kb + ((d0 >> 3) & 3) * 128 + (d0 & 7)) = w0;
              *(uint2*)(kb + (((d0 + 16) >> 3) & 3) * 128 + (d0 & 7)) = w1;
            }
          }
        } else if (cb < 35) {
          const int cv = col - 4224;
#pragma unroll
          for (int m = 0; m < 4; ++m) {
            const int row = row0 + m * 16;
            int s, tile, u; kv_tile_of_row(row, s, tile, u);
#pragma unroll
            for (int n = 0; n < 2; ++n)
#pragma unroll
              for (int j = 0; j < 4; ++j) {
                const int c2 = cv + n * 16 + j; const int hk = c2 >> 6, dim = c2 & 63;
                p.VT[((size_t)(((s * 4 + hk) * 136 + tile) * 4 + (dim >> 4)) * 64 + (u >> 3) * 16 + (dim & 15)) * 8 + (u & 7)] = f2bf(acc[ai][bj][m][n][j]);
              }
          }
        }
      } else if (EPI == EPI_OUT || EPI == EPI_DOWN) {
#pragma unroll
        for (int m = 0; m < 4; ++m) {
          const int row = row0 + m * 16;
          const float* gt = p.MOD + ((size_t)(layer * 3 + mod_vec(row)) * 6 + (EPI == EPI_OUT ? 2 : 5)) * D;
          const float* rs = (EPI == EPI_OUT && layer == 0) ? resid_in(p, row) : p.X + (size_t)row * D;
#pragma unroll
          for (int n = 0; n < 2; ++n) {
            const int c2 = col + n * 16;
            const f32x4 r = *(const f32x4*)(rs + c2), g = *(const f32x4*)(gt + c2);
            *(f32x4*)(p.X + (size_t)row * D + c2) = r + g * acc[ai][bj][m][n];
          }
        }
      } else {
        const int hc = ((bcol + bj * 128 + wc * 32) >> 5) * 16 + fq * 4;
#pragma unroll
        for (int m = 0; m < 4; ++m) {
          const f32x4 g = acc[ai][bj][m][0], u = acc[ai][bj][m][1];
          const float h0 = g[0] * sigmoidf_(g[0]) * u[0], h1 = g[1] * sigmoidf_(g[1]) * u[1], h2 = g[2] * sigmoidf_(g[2]) * u[2], h3 = g[3] * sigmoidf_(g[3]) * u[3];
          uint2 w; w.x = pk_bf16(h0, h1); w.y = pk_bf16(h2, h3);
          *(uint2*)(p.HID + (size_t)(row0 + m * 16) * FH + hc) = w;
        }
      }
    }
}

template <int EPI>
__device__ void gemm_phase(const P& p, int layer, const bf16_t* __restrict__ A0, const bf16_t* __restrict__ Bt0, int M, int N, int K, char* lds,
                           int Mfull = 1 << 30, int nsl = 1, float* slab = nullptr) {
  using namespace g8;
  const int tid = rtid(), wid = tid >> 6, lane = tid & 63, wr = wid >> 2, wc = wid & 3, fr = lane & 15, fq = lane >> 4;
  const int nMf = min(M, Mfull) / BM, nN = N / BM, nwg = nMf * nN, ntf = K / BK;
  const int nsplit = (M / BM - nMf) * nN * nsl, ntsl = ntf / nsl, nitems = nwg + nsplit;
  unsigned voff;
  { int R, C; stage_rc(tid * 16, R, C); voff = (unsigned)(R * K + C) * 2u; }
  const int aoff = lds_byte(wr * 64 + fr, fq * 8), boff = lds_byte(wc * 32 + fr, fq * 8);
  const unsigned ldsw = (unsigned)__builtin_amdgcn_readfirstlane(wid) * 1024u;
  typedef __attribute__((address_space(3))) unsigned char* lds_p;
  const lds_p ldsl = (lds_p)lds;
  const size_t kstep = (size_t)BK * 2, hstep = (size_t)HALF * K * 2, pstep = (size_t)64 * K * 2;
#define G8_SA(b, h) (((b) * 2 + (h)) * HTB)
#define G8_SB(b, h) ((4 + (b) * 2 + (h)) * HTB)
#define G8_STAGE(bufoff, gp) do { const char* _g = (gp); \
    __builtin_amdgcn_global_load_lds((const unsigned*)(_g + voff), (__attribute__((address_space(3))) unsigned*)(ldsl + (bufoff) + ldsw), 16, 0, 0); \
    __builtin_amdgcn_global_load_lds((const unsigned*)(_g + pstep + voff), (__attribute__((address_space(3))) unsigned*)(ldsl + (bufoff) + ldsw + 8192), 16, 0, 0); } while (0)
#define G8_LDA(dst, b, h) do { _Pragma("unroll") for (int m = 0; m < 4; ++m) _Pragma("unroll") for (int k = 0; k < 2; ++k) dst[m][k] = *(const __attribute__((address_space(3))) bf16x8*)(ldsl + G8_SA(b, h) + aoff + m * 2048 + k * 1024); } while (0)
#define G8_LDB(dst, b, h) do { _Pragma("unroll") for (int n = 0; n < 2; ++n) _Pragma("unroll") for (int k = 0; k < 2; ++k) dst[n][k] = *(const __attribute__((address_space(3))) bf16x8*)(ldsl + G8_SB(b, h) + boff + n * 2048 + k * 1024); } while (0)
#define G8_MMA(ai, bj, At_, Bt_) do { __builtin_amdgcn_s_setprio(1); _Pragma("unroll") for (int m = 0; m < 4; ++m) _Pragma("unroll") for (int n = 0; n < 2; ++n) _Pragma("unroll") for (int k = 0; k < 2; ++k) \
    acc[ai][bj][m][n] = __builtin_amdgcn_mfma_f32_16x16x32_bf16(Bt_[n][k], At_[m][k], acc[ai][bj][m][n], 0, 0, 0); __builtin_amdgcn_s_setprio(0); } while (0)
#define WAIT_V(n) asm volatile("s_waitcnt vmcnt(" #n ")" ::: "memory")
#define WAIT_L(n) asm volatile("s_waitcnt lgkmcnt(" #n ")" ::: "memory")
#define BAR __builtin_amdgcn_s_barrier()
#define SCHED __builtin_amdgcn_sched_barrier(0)
#define G8_DECODE(L_, pm_, pn_, nt_, slice_, cA_, cB_, split_) do { nt_ = ntf; slice_ = 0; split_ = (L_) >= nwg; size_t ko_ = 0; \
    if (!split_) { int wgid = (L_); \
      { const int q = nwg / NXCD, r = nwg % NXCD, xcd = wgid % NXCD, off = wgid / NXCD; wgid = (xcd < r ? xcd * (q + 1) : r * (q + 1) + (xcd - r) * q) + off; } \
      const int nig = WGM * nN, gid = wgid / nig, fm = gid * WGM, gsz = min(nMf - fm, WGM); \
      pm_ = fm + ((wgid % nig) % gsz); pn_ = (wgid % nig) / gsz; \
    } else { const int s_ = (L_) - nwg, tile_ = s_ / nsl; slice_ = s_ % nsl; pm_ = nMf + tile_ / nN; pn_ = tile_ % nN; nt_ = ntsl; ko_ = (size_t)slice_ * ntsl * BK; } \
    cA_ = (const char*)(A0 + (size_t)(pm_) * BM * K + ko_); cB_ = (const char*)(Bt0 + (size_t)(pn_) * BM * K + ko_); } while (0)
  int L = rbid();
  if (L >= nitems) return;
  int pm, pn, nt, slice; const char* cA; const char* cB; bool split;
  G8_DECODE(L, pm, pn, nt, slice, cA, cB, split);
  f32x4 acc[2][2][4][2];
#pragma unroll
  for (int a = 0; a < 2; ++a)
#pragma unroll
    for (int b = 0; b < 2; ++b)
#pragma unroll
      for (int m = 0; m < 4; ++m)
#pragma unroll
        for (int n = 0; n < 2; ++n) acc[a][b][m][n] = (f32x4){0.f, 0.f, 0.f, 0.f};
  bf16x8 At[4][2], B0[2][2], B1[2][2];
  G8_STAGE(G8_SB(0, 0), cB); G8_STAGE(G8_SB(0, 1), cB + hstep); G8_STAGE(G8_SA(0, 0), cA); G8_STAGE(G8_SA(0, 1), cA + hstep);
  if (wr == 1) BAR;
  WAIT_V(2); BAR;
  G8_STAGE(G8_SB(1, 0), cB + kstep); G8_STAGE(G8_SA(1, 0), cA + kstep); G8_STAGE(G8_SB(1, 1), cB + hstep + kstep);
  WAIT_V(6); BAR;
  for (;;) {
    const int Ln = L + (int)gridDim.x; const bool has_next = Ln < nitems;
    const char* nA = cA; const char* nB = cB;
    if (has_next) { int pm2, pn2, nt2, slice2; bool split2; G8_DECODE(Ln, pm2, pn2, nt2, slice2, nA, nB, split2); }
    for (int t = 0; t < nt; t += 2) {
      const bool last = (t == nt - 2);
      const char* a1 = cA + (size_t)(t + 1) * kstep;
      const char* a2 = last ? nA : cA + (size_t)(t + 2) * kstep; const char* b2 = last ? nB : cB + (size_t)(t + 2) * kstep;
      const char* a3 = a2 + kstep; const char* b3 = b2 + kstep;
      G8_LDB(B0, 0, 0); G8_LDB(B1, 0, 1); SCHED; G8_LDA(At, 0, 0); G8_STAGE(G8_SA(1, 1), a1 + hstep);
      WAIT_V(8); WAIT_L(0); BAR; G8_MMA(0, 0, At, B0); G8_MMA(0, 1, At, B1); BAR; SCHED;
      G8_LDA(At, 0, 1); G8_STAGE(G8_SB(0, 0), b2); G8_STAGE(G8_SB(0, 1), b2 + hstep); G8_STAGE(G8_SA(0, 0), a2);
      WAIT_V(8); WAIT_L(0); BAR; G8_MMA(1, 0, At, B0); G8_MMA(1, 1, At, B1); BAR; SCHED;
      G8_LDB(B0, 1, 0); G8_LDB(B1, 1, 1); SCHED; G8_LDA(At, 1, 0); G8_STAGE(G8_SA(0, 1), a2 + hstep);
      WAIT_V(8); WAIT_L(0); BAR; G8_MMA(0, 0, At, B0); G8_MMA(0, 1, At, B1); BAR; SCHED;
      G8_LDA(At, 1, 1); G8_STAGE(G8_SB(1, 0), b3); G8_STAGE(G8_SB(1, 1), b3 + hstep); G8_STAGE(G8_SA(1, 0), a3);
      WAIT_V(8); WAIT_L(0); BAR; G8_MMA(1, 0, At, B0); G8_MMA(1, 1, At, B1); BAR; SCHED;
    }
    if (wr == 0) BAR;
    const int brow = pm * BM, bcol = pn * BM;
    if (!split) epi8<EPI>(p, layer, acc, brow, bcol, wr, wc, fr, fq);
    else {
      float* sp = slab + ((size_t)slice * (M - Mfull) + (brow - Mfull + wr * 64 + fr)) * N + bcol + wc * 32 + fq * 4;
#pragma unroll
      for (int ai = 0; ai < 2; ++ai)
#pragma unroll
        for (int bj = 0; bj < 2; ++bj)
#pragma unroll
          for (int m = 0; m < 4; ++m)
#pragma unroll
            for (int n = 0; n < 2; ++n) *(f32x4*)(sp + (size_t)(ai * 128 + m * 16) * N + bj * 128 + n * 16) = acc[ai][bj][m][n];
    }
    if (!has_next) break;
#pragma unroll
    for (int a = 0; a < 2; ++a)
#pragma unroll
      for (int b = 0; b < 2; ++b)
#pragma unroll
        for (int m = 0; m < 4; ++m)
#pragma unroll
          for (int n = 0; n < 2; ++n) acc[a][b][m][n] = (f32x4){0.f, 0.f, 0.f, 0.f};
    L = Ln;
    G8_DECODE(L, pm, pn, nt, slice, cA, cB, split);
    if (wr == 1) BAR;
  }
  WAIT_V(0);
  BAR;
#undef G8_DECODE
#undef G8_SA
#undef G8_SB
#undef G8_STAGE
#undef G8_LDA
#undef G8_LDB
#undef G8_MMA
#undef WAIT_V
#undef WAIT_L
#undef BAR
#undef SCHED
}

__device__ __forceinline__ void seq_bounds(int row, int& s0, int& s1) {
  if (row < NLAT) { s0 = row & ~(T - 1); s1 = s0 + T; } else { s0 = NLAT + ((row - NLAT) & ~(CTX - 1)); s1 = s0 + CTX; }
}
__device__ __forceinline__ float shifted(const float* __restrict__ Z, const float* __restrict__ mu, int row, bool hp, bool hn, int col) {
  float z = Z[zidx(row, col)];
  float zm = hp ? Z[zidx(row - 1, col)] : 0.f;
  float zp = hn ? Z[zidx(row + 1, col)] : 0.f;
  return z + mu[col] * (0.5f * (zm + zp) - z);
}

__device__ __forceinline__ f32x4 shifted4(const float* __restrict__ Z, const float* __restrict__ mu, int row, bool hp, bool hn, int col) {
  const f32x4 z = *(const f32x4*)(Z + zidx(row, col));
  f32x4 zm = {0.f, 0.f, 0.f, 0.f}, zp = zm;
  if (hp) zm = *(const f32x4*)(Z + zidx(row - 1, col));
  if (hn) zp = *(const f32x4*)(Z + zidx(row + 1, col));
  const f32x4 m = *(const f32x4*)(mu + col);
  return z + m * ((zm + zp) * 0.5f - z);
}

__device__ void prep_task(const P& p, int layer, int task, int hh0, int hh1, char* lds) {
  bf16_t* xs = (bf16_t*)lds;
  const int tid = otid(), lane = tid & 63, wave = tid >> 6, fr = lane & 15, fq = lane >> 4;
  const int row0 = task * 16;
  int s0, s1; seq_bounds(row0, s0, s1);
  const float* mu = p.mu + layer * 2688;
#pragma unroll 2
  for (int i = 0; i < 6; ++i) {
    const int idx = tid + NT * i; const int tok = idx / 96, cc = (idx % 96) * 4;
    const int rw = row0 + tok;
    const f32x4 sv = shifted4(p.Z, mu, rw, rw > s0, rw < s1 - 1, 2304 + cc);
    f32x4 t;
#pragma unroll
    for (int j = 0; j < 4; ++j) {
      float v = sv[j];
      if (cc < 128) v = 1.f - 2.f * __builtin_amdgcn_rcpf(1.f + __expf(2.f * v));
      else if (cc >= 256) v = sigmoidf_(v);
      t[j] = v;
    }
    uint2 w; w.x = pk_bf16(t[0], t[1]); w.y = pk_bf16(t[2], t[3]);
    *(uint2*)(xs + tok * 392 + cc) = w;
  }
  __syncthreads();
  const bf16_t* wl = p.WLR + (size_t)layer * DR * 384;
  const int row = row0 + fr;
  const bool hp = row > s0, hn = row < s1 - 1;
  const float* pw0 = p.w0 + layer * 2 * DR; const float* pa0 = p.a0 + layer * 2 * DR;
  const float* pkk = p.k_k + layer * DR; const float* pka = p.k_a + layer * DR; const float* prk = p.r_k + layer * DR;
#pragma unroll 1
  for (int hh = hh0; hh < hh1; ++hh) {
    const int h = wave + 4 * hh;
    const bf16_t* xp = xs + fr * 392 + fq * 8;
    float ss = 0.f;
#pragma unroll
    for (int ct = 0; ct < 4; ++ct) {
      const int c = h * 64 + ct * 16 + fq * 4;
      const f32x4 kx = shifted4(p.Z, mu, row, hp, hn, DR + c);
      const f32x4 kkw = *(const f32x4*)(pkk + c);
#pragma unroll
      for (int j = 0; j < 4; ++j) { const float kk = kx[j] * kkw[j]; ss += kk * kk; }
    }
    ss += __shfl_xor(ss, 16); ss += __shfl_xor(ss, 32);
    const float kinv = 1.f / fmaxf(sqrtf(ss), 1e-12f);
    float sd = 0.f;
    const size_t tb = (size_t)task * 12 + h;
    float* so0 = p.SOPS + tb * 3072 + fr * 16 + fq * 4;
    float* so1 = p.SOPS + ((size_t)(NTOK / 16) * 12 + tb) * 3072 + fr * 16 + fq * 4;
    float* sh = p.SHR + tb * 3072 + fr * 16 + fq * 4;
    bf16_t* gbp = (bf16_t*)p.GB + tb * 1024 + fr * 16 + fq * 4;
    bf16x8 wcur[12];
    { const bf16_t* wp = wl + ((size_t)(h * 4) * 12 * 64 + lane) * 8;
#pragma unroll
      for (int ks = 0; ks < 12; ++ks) wcur[ks] = *(const bf16x8*)(wp + ks * 512); }
#pragma unroll 1
    for (int ct = 0; ct < 4; ++ct) {
      bf16x8 wnx[12];
      { const bf16_t* wp = wl + ((size_t)(h * 4 + min(ct + 1, 3)) * 12 * 64 + lane) * 8;
#pragma unroll
        for (int ks = 0; ks < 12; ++ks) wnx[ks] = *(const bf16x8*)(wp + ks * 512); }
      asm volatile("" ::: "memory");
      const f32x4 z4 = {0.f, 0.f, 0.f, 0.f};
      f32x4 aw0 = z4, aw1 = z4, aa0 = z4, aa1 = z4, ag = z4;
#pragma unroll
      for (int ks = 0; ks < 12; ++ks) {
        const bf16x8 wf = wcur[ks], xf = *(const bf16x8*)(xp + ks * 32);
        if (ks < 2) aw0 = __builtin_amdgcn_mfma_f32_16x16x32_bf16(wf, xf, aw0, 0, 0, 0);
        else if (ks < 4) aw1 = __builtin_amdgcn_mfma_f32_16x16x32_bf16(wf, xf, aw1, 0, 0, 0);
        else if (ks < 6) aa0 = __builtin_amdgcn_mfma_f32_16x16x32_bf16(wf, xf, aa0, 0, 0, 0);
        else if (ks < 8) aa1 = __builtin_amdgcn_mfma_f32_16x16x32_bf16(wf, xf, aa1, 0, 0, 0);
        else ag = __builtin_amdgcn_mfma_f32_16x16x32_bf16(wf, xf, ag, 0, 0, 0);
      }
      const int c = h * 64 + ct * 16 + fq * 4;
      const f32x4 rr = shifted4(p.Z, mu, row, hp, hn, c), kx = shifted4(p.Z, mu, row, hp, hn, DR + c), vv = shifted4(p.Z, mu, row, hp, hn, 2 * DR + c);
      const f32x4 w00 = *(const f32x4*)(pw0 + c), w01 = *(const f32x4*)(pw0 + DR + c);
      const f32x4 a00 = *(const f32x4*)(pa0 + c), a01 = *(const f32x4*)(pa0 + DR + c);
      const f32x4 kkw = *(const f32x4*)(pkk + c), kaw = *(const f32x4*)(pka + c), rkw = *(const f32x4*)(prk + c);
      f32x4 dec0, dec1, kd0, kd1, bd0, bd1, av;
#pragma unroll
      for (int j = 0; j < 4; ++j) {
        dec0[j] = __expf(-0.6065306597126334f * sigmoidf_(w00[j] + aw0[j]));
        dec1[j] = __expf(-0.6065306597126334f * sigmoidf_(w01[j] + aw1[j]));
        const float ad0 = sigmoidf_(a00[j] + aa0[j]), ad1 = sigmoidf_(a01[j] + aa1[j]);
        const float kk = kx[j] * kkw[j] * kinv;
        kd0[j] = kx[j] * (1.f + (ad0 - 1.f) * kaw[j]); kd1[j] = kx[j] * (1.f + (ad1 - 1.f) * kaw[j]);
        bd0[j] = kk * ad0; bd1[j] = kk * ad1; av[j] = -kk;
        sd += rr[j] * (kd0[j] + kd1[j]) * rkw[j];
      }
      const int o = ct * 256;
      *(f32x4*)(so0 + o) = dec0; *(f32x4*)(so0 + 1024 + o) = kd0; *(f32x4*)(so0 + 2048 + o) = bd0;
      *(f32x4*)(so1 + o) = dec1; *(f32x4*)(so1 + 1024 + o) = kd1; *(f32x4*)(so1 + 2048 + o) = bd1;
      *(f32x4*)(sh + o) = av; *(f32x4*)(sh + 1024 + o) = rr; *(f32x4*)(sh + 2048 + o) = vv;
      { uint2 gw_; gw_.x = pk_bf16(ag[0], ag[1]); gw_.y = pk_bf16(ag[2], ag[3]); *(uint2*)(gbp + o) = gw_; }
#pragma unroll
      for (int ks = 0; ks < 12; ++ks) wcur[ks] = wnx[ks];
    }
    sd += __shfl_xor(sd, 16); sd += __shfl_xor(sd, 32);
    if (fq == 0) p.BON[(size_t)row * 12 + h] = sd;
  }
  __syncthreads();
}

template <bool SOFT>
__device__ void pool_task(const P& p, int layer, int task, char* lds, HalfBar& hb) {
  float* raw = (float*)lds;
  bf16_t* mmb = (bf16_t*)(raw + 48 * 128);
  const int tid = otid();
  const int gi = task & 3, row0 = (task >> 2) * 32;
  int s0, s1; seq_bounds(row0, s0, s1);
  const int w = 2 << gi, half = w >> 1;
#pragma unroll 2
  for (int i = 0; i < 6; ++i) {
    const int idx = tid + NT * i; const int pp = idx >> 5, c4 = (idx & 31) * 4;
    const int row = row0 - 8 + pp;
    f32x4 v = {0.f, 0.f, 0.f, 0.f};
    if (row >= s0 && row < s1) v = *(const f32x4*)(p.Z + zidx(row, 2688 + gi * 128 + c4));
    *(f32x4*)(raw + pp * 128 + c4) = v;
  }
  vbar<SOFT>(hb);
#pragma unroll 1
  for (int i = 0; i < 4; ++i) {
    const int idx = tid + NT * i; const int tok = idx >> 5, c4 = (idx & 31) * 4;
    const int row = row0 + tok;
    const int lo = max(row - half, s0), hi = min(row + half, s1);
    f32x4 sum = {0.f, 0.f, 0.f, 0.f};
    for (int r = lo; r < hi; ++r) sum += *(const f32x4*)(raw + (r - row0 + 8) * 128 + c4);
    const f32x4 m = sum * __builtin_amdgcn_rcpf((float)(hi - lo)) - *(const f32x4*)(raw + (tok + 8) * 128 + c4);
    uint2 w; w.x = pk_bf16(m[0], m[1]); w.y = pk_bf16(m[2], m[3]);
    *(uint2*)(mmb + tok * 136 + c4) = w;
  }
  vbar<SOFT>(hb);
  const int lane = tid & 63, wave = tid >> 6, fr = lane & 15, fq = lane >> 4;
  const bf16_t* pf = p.PWF + (size_t)(layer * 4 + gi) * (8 * 4 * 64 * 8);
#pragma unroll
  for (int qq = 0; qq < 2; ++qq) {
    const int nt = wave * 2 + qq;
    f32x4 acc0 = {0.f, 0.f, 0.f, 0.f}, acc1 = acc0;
#pragma unroll
    for (int ks = 0; ks < 4; ++ks) {
      const bf16x8 wf = *(const bf16x8*)(pf + ((size_t)(nt * 4 + ks) * 64 + lane) * 8);
      const bf16x8 m0 = *(const bf16x8*)(mmb + fr * 136 + ks * 32 + fq * 8), m1 = *(const bf16x8*)(mmb + (16 + fr) * 136 + ks * 32 + fq * 8);
      acc0 = __builtin_amdgcn_mfma_f32_16x16x32_bf16(wf, m0, acc0, 0, 0, 0);
      acc1 = __builtin_amdgcn_mfma_f32_16x16x32_bf16(wf, m1, acc1, 0, 0, 0);
    }
    const int d0 = nt * 16 + fq * 4;
    const f32x4 sc = *(const f32x4*)(p.pool_scale + layer * 512 + gi * 128 + d0);
    uint2 w;
    w.x = pk_bf16(acc0[0] * sc[0], acc0[1] * sc[1]); w.y = pk_bf16(acc0[2] * sc[2], acc0[3] * sc[3]);
    *(uint2*)(p.HB + (size_t)(row0 + fr) * D + DR + gi * 128 + d0) = w;
    w.x = pk_bf16(acc1[0] * sc[0], acc1[1] * sc[1]); w.y = pk_bf16(acc1[2] * sc[2], acc1[3] * sc[3]);
    *(uint2*)(p.HB + (size_t)(row0 + 16 + fr) * D + DR + gi * 128 + d0) = w;
  }
  vbar<SOFT>(hb);
}

__device__ void attn_wave_task(const P& p, int layer, int wt) {
  const int lane = otid() & 63, fr = lane & 15, fq = lane >> 4;
  int b, qh, t0, qrow0; bool lat;
  if (wt < 6144) { lat = true; b = wt / 3072; int r = wt % 3072; const int hk_ = r / 768; r %= 768; qh = hk_ * 3 + r % 3; t0 = (r / 3) * 16; qrow0 = b * T + t0; }
  else { lat = false; int r = wt - 6144; b = r / 192; r %= 192; const int hk_ = r / 48; r %= 48; qh = hk_ * 3 + r % 3; t0 = (r / 3) * 16; qrow0 = NLAT + b * CTX + t0; }
  const int hk = qh / 3;
  bf16x8 qf[2];
  qf[0] = *(const bf16x8*)(p.QB + (size_t)(qrow0 + fr) * DR + qh * 64 + fq * 8);
  qf[1] = *(const bf16x8*)(p.QB + (size_t)(qrow0 + fr) * DR + qh * 64 + 32 + fq * 8);
  float m_run = -1e30f, l_run = 0.f;
  f32x4 o[4];
#pragma unroll
  for (int i = 0; i < 4; ++i) o[i] = (f32x4){0.f, 0.f, 0.f, 0.f};
  const int qpos = t0 + fr;
  int nwin = 0, kw0 = 0;
  if (lat) { kw0 = max(t0 - 128, 0) & ~31; int kend = min(T, t0 + 16 + 128); nwin = (kend - kw0 + 31) >> 5; }
  const int ntile = nwin + 8;
  const bf16_t* vbase = p.VT + (size_t)(b * 4 + hk) * 64 * VTS;
  const int kperm = 8 * (fr >> 2) + (fr & 3);
#define ATT_LOAD(it_, K00, K01, K10, K11, V0, V1, V2, V3) { \
    const int tile_ = (it_) < nwin ? ((kw0 >> 5) + (it_)) : 128 + ((it_) - nwin); \
    const size_t tb_ = ((size_t)((b * 4 + hk) * 136 + tile_) * 4 * 64 + lane) * 8; \
    const bf16_t* kp_ = p.KB + tb_; \
    K00 = *(const bf16x8*)(kp_); K01 = *(const bf16x8*)(kp_ + 512); K10 = *(const bf16x8*)(kp_ + 1024); K11 = *(const bf16x8*)(kp_ + 1536); \
    const bf16_t* vp_ = p.VT + tb_; \
    V0 = *(const bf16x8*)(vp_); V1 = *(const bf16x8*)(vp_ + 512); V2 = *(const bf16x8*)(vp_ + 1024); V3 = *(const bf16x8*)(vp_ + 1536); }
  bf16x8 k00, k01, k10, k11, v0, v1, v2, v3;
  ATT_LOAD(0, k00, k01, k10, k11, v0, v1, v2, v3)
  for (int it = 0; it < ntile; ++it) {
    const bool win = it < nwin;
    const int kpos0 = kw0 + it * 32;
    bf16x8 n00, n01, n10, n11, nv0, nv1, nv2, nv3;
    { const int itn = min(it + 1, ntile - 1); ATT_LOAD(itn, n00, n01, n10, n11, nv0, nv1, nv2, nv3) }
    asm volatile("" ::: "memory");
    f32x4 s[2];
    s[0] = (f32x4){0.f, 0.f, 0.f, 0.f}; s[1] = s[0];
    s[0] = __builtin_amdgcn_mfma_f32_16x16x32_bf16(k00, qf[0], s[0], 0, 0, 0);
    s[1] = __builtin_amdgcn_mfma_f32_16x16x32_bf16(k10, qf[0], s[1], 0, 0, 0);
    s[0] = __builtin_amdgcn_mfma_f32_16x16x32_bf16(k01, qf[1], s[0], 0, 0, 0);
    s[1] = __builtin_amdgcn_mfma_f32_16x16x32_bf16(k11, qf[1], s[1], 0, 0, 0);
    float mloc = -1e30f;
    bool valid[2][4];
#pragma unroll
    for (int kk = 0; kk < 2; ++kk)
#pragma unroll
      for (int r = 0; r < 4; ++r) {
        bool v = true;
        if (win) { int kpos = kpos0 + 8 * fq + 4 * kk + r; int dlt = kpos - qpos; v = (dlt <= 128) && (dlt >= -128); }
        valid[kk][r] = v;
        if (v) mloc = fmaxf(mloc, s[kk][r]);
      }
    mloc = fmaxf(mloc, __shfl_xor(mloc, 16));
    mloc = fmaxf(mloc, __shfl_xor(mloc, 32));
    const float m_new = fmaxf(m_run, mloc);
    const float alpha = __expf(m_run - m_new);
    float pv[8]; float ps = 0.f;
#pragma unroll
    for (int kk = 0; kk < 2; ++kk)
#pragma unroll
      for (int r = 0; r < 4; ++r) { float e = valid[kk][r] ? __expf(s[kk][r] - m_new) : 0.f; pv[kk * 4 + r] = e; ps += e; }
    l_run = l_run * alpha + ps;
    m_run = m_new;
    union { bf16x8 v; unsigned u[4]; } pf;
    pf.u[0] = pk_bf16(pv[0], pv[1]); pf.u[1] = pk_bf16(pv[2], pv[3]); pf.u[2] = pk_bf16(pv[4], pv[5]); pf.u[3] = pk_bf16(pv[6], pv[7]);
    o[0] = o[0] * alpha; o[1] = o[1] * alpha; o[2] = o[2] * alpha; o[3] = o[3] * alpha;
    o[0] = __builtin_amdgcn_mfma_f32_16x16x32_bf16(v0, pf.v, o[0], 0, 0, 0);
    o[1] = __builtin_amdgcn_mfma_f32_16x16x32_bf16(v1, pf.v, o[1], 0, 0, 0);
    o[2] = __builtin_amdgcn_mfma_f32_16x16x32_bf16(v2, pf.v, o[2], 0, 0, 0);
    o[3] = __builtin_amdgcn_mfma_f32_16x16x32_bf16(v3, pf.v, o[3], 0, 0, 0);
    k00 = n00; k01 = n01; k10 = n10; k11 = n11; v0 = nv0; v1 = nv1; v2 = nv2; v3 = nv3;
  }
#undef ATT_LOAD
  l_run += __shfl_xor(l_run, 16);
  l_run += __shfl_xor(l_run, 32);
  l_run += __expf(p.sink[layer * 12 + qh] - m_run);
  const float inv = 1.f / l_run;
#pragma unroll
  for (int dt = 0; dt < 4; ++dt) {
    uint2 w; w.x = pk_bf16(o[dt][0] * inv, o[dt][1] * inv); w.y = pk_bf16(o[dt][2] * inv, o[dt][3] * inv);
    *(uint2*)(p.HB + (size_t)(qrow0 + fr) * D + 1280 + qh * 64 + dt * 16 + fq * 4) = w;
  }
}

__device__ void mix_phase(const P& p, int layer, char* lds) {
  const int ntask = NTOK / 16, nfull = min(ntask, VG);
  UNIFORM_TASKS(t, nfull, obid(), VG, 2, prep_task(p, layer, t, 0, 3, lds))
  UNIFORM_TASKS(it, (ntask - nfull) * 3, obid(), VG, 2, prep_task(p, layer, nfull + it / 3, it % 3, it % 3 + 1, lds))
}

__device__ void convert_rest(const P& p, int layer, int ob, int nb, char* lds, HalfBar& hb) {
  float* s = (float*)lds;
  constexpr int T_IN = 32 * 70, T_OUT = 32 * 32, T_GU = 32 * 176, T_DN = 88 * 32, T_L = T_IN + T_OUT + T_GU + T_DN;
  const int beg = layer == 0 ? T_IN : T_L + T_IN, end = layer == 0 ? T_L + T_IN : 2 * T_L;
  for (int it = beg + ob; it < end; it += nb) {
    int l = it / T_L, t = it % T_L;
    if (t < T_IN) convert_tile<true>(p.w_in + (size_t)l * D * DIN, D, DIN, p.wt_in + (size_t)l * DINP * D, 0, t, s, hb);
    else if (t < T_IN + T_OUT) convert_tile<true>(p.w_out + (size_t)l * D * D, D, D, p.wt_out + (size_t)l * D * D, 0, t - T_IN, s, hb);
    else if (t < T_IN + T_OUT + T_GU) convert_tile<true>(p.w_gu + (size_t)l * D * 2 * FH, D, 2 * FH, p.wt_gu + (size_t)l * 2 * FH * D, 1, t - T_IN - T_OUT, s, hb);
    else convert_tile<true>(p.w_down + (size_t)l * FH * D, FH, D, p.wt_down + (size_t)l * D * FH, 0, t - T_IN - T_OUT - T_GU, s, hb);
  }
}

typedef float f32x2 __attribute__((ext_vector_type(2)));
__device__ void scan_phase(const P& p, int layer, char* lds, volatile __attribute__((address_space(3))) unsigned* hbw) {
  const int rb = rbid(), half = __builtin_amdgcn_readfirstlane(threadIdx.x >> 8);
  __syncthreads();
  if (otid() == 0) hbw[half * 4] = 0u;
  __syncthreads();
  HalfBar hb{hbw + half * 4, 0u};
  const bool scanner = rb < 192 && half == 0;
  const int bid = rb;
  if (!scanner) {
    const int nb = 192 + ((int)gridDim.x - 192) * 2, ob = rb < 192 ? rb : 192 + (rb - 192) * 2 + half;
    const int npool = (layer == 0 ? NTOK : NLAT) / 32 * 4;
    for (int t = ob; t < npool; t += nb) pool_task<true>(p, layer, t, lds, hb);
    const int nat = layer == 0 ? 6144 + 384 : 6144;
    for (int wt = ob * 4 + (otid() >> 6); wt < nat; wt += nb * 4) attn_wave_task(p, layer, wt);
    vbar<true>(hb);
    convert_rest(p, layer, ob, nb, lds, hb);
    return;
  }
  __builtin_amdgcn_s_setprio(3);
  const int tid = otid(), lane = tid & 63, wave = tid >> 6;
  const int chain = bid >> 2, rq = bid & 3;
  const int b = chain / 24, d = (chain / 12) & 1, h = chain % 12;
  const int rl = lane >> 4, q = lane & 15;
  const int ri = rq * 16 + wave * 4 + rl;
  const int sgn = d ? -1 : 1;
  constexpr int TC = 16, NCH = (CTX + T) / TC, RS = 12 * 192;
  float4* l4 = (float4*)lds;
#define ROWBASE(c) ((c) < CTX / TC ? NLAT + b * CTX + (d ? CTX - 1 - (c) * TC : (c) * TC) : b * T + (d ? T - 1 - ((c) - CTX / TC) * TC : ((c) - CTX / TC) * TC))
  const float *bp0, *bp1, *bp2, *bp3, *bp4, *bp5; int lo0, lo1, lo2, lo3, lo4, lo5;
#define SCAN_BP(BP, LO, i) { const int gi = tid + NT * (i); const int sh_ = gi >= 768 ? 1 : 0; const int g = gi - sh_ * 768; \
    const int vec = g >> 8, ct = (g >> 6) & 3, tk = (g >> 2) & 15, fq_ = g & 3; const int st = d ? 15 - tk : tk; \
    LO = st * 96 + sh_ * 48 + vec * 16 + ct * 4 + fq_; \
    BP = (sh_ ? p.SHR + (size_t)h * 3072 : p.SOPS + ((size_t)d * (NTOK / 16) * 12 + h) * 3072) + g * 4; }
  SCAN_BP(bp0, lo0, 0) SCAN_BP(bp1, lo1, 1) SCAN_BP(bp2, lo2, 2) SCAN_BP(bp3, lo3, 3) SCAN_BP(bp4, lo4, 4) SCAN_BP(bp5, lo5, 5)
  float* const ybp = p.YB + ((size_t)d * NTOK * DR + h * 64 + ri) + (ptrdiff_t)(sgn * q) * DR;
  float4 ra0, ra1, ra2, ra3, ra4, ra5, rb0, rb1, rb2, rb3, rb4, rb5;
#define load_chunk(c, R) { const size_t ro = (size_t)((ROWBASE(c) - (d ? 15 : 0)) >> 4) * (12 * 3072); R##0 = *(const float4*)(bp0 + ro); R##1 = *(const float4*)(bp1 + ro); R##2 = *(const float4*)(bp2 + ro); \
    R##3 = *(const float4*)(bp3 + ro); R##4 = *(const float4*)(bp4 + ro); R##5 = *(const float4*)(bp5 + ro); }
#define store_chunk(buf, R) { float4* lp = l4 + (buf) * (TC * 96); lp[lo0] = R##0; lp[lo1] = R##1; lp[lo2] = R##2; lp[lo3] = R##3; lp[lo4] = R##4; lp[lo5] = R##5; }
#define LDSTEP(sp, W, K, B, A, R, V) { W = *(const f32x4*)((sp) + 4 * q); K = *(const f32x4*)((sp) + 64 + 4 * q); B = *(const f32x4*)((sp) + 128 + 4 * q); \
    A = *(const f32x4*)((sp) + 192 + 4 * q); R = *(const f32x4*)((sp) + 256 + 4 * q); V = (sp)[320 + ri]; }
#define SCAN_CHUNK(c, cur) { \
    const float* base = (const float*)lds + (cur) * (TC * 384); \
    f32x4 w4, k4, b4, a4, r4; float v; \
    LDSTEP(base, w4, k4, b4, a4, r4, v) \
    float ykeep = 0.f; \
    _Pragma("unroll") \
    for (int st = 0; st < TC; ++st) { \
      f32x4 nw, nk, nb, na, nr; float nv; \
      if (st + 1 < TC) LDSTEP(base + (st + 1) * 384, nw, nk, nb, na, nr, nv) \
      f32x2 pa = S01 * a4.lo; \
      pa = S23 * a4.hi + pa; \
      const f32x2 t01 = S01 * w4.lo + k4.lo * v, t23 = S23 * w4.hi + k4.hi * v; \
      const float sa = reduce16(pa.x + pa.y); \
      S01 = b4.lo * sa + t01; \
      S23 = b4.hi * sa + t23; \
      f32x2 py = S01 * r4.lo; \
      py = S23 * r4.hi + py; \
      const float y = reduce16(py.x + py.y); \
      ykeep = (q == st) ? y : ykeep; \
      if (st + 1 < TC) { w4 = nw; k4 = nk; b4 = nb; a4 = na; r4 = nr; v = nv; } \
    } \
    ybp[(size_t)(ROWBASE(c)) * DR] = ykeep; }
  f32x2 S01 = {0.f, 0.f}, S23 = {0.f, 0.f};
  load_chunk(0, ra); store_chunk(0, ra); load_chunk(1, ra); load_chunk(2, rb);
  vbar<true>(hb);
  for (int c = 0; c < NCH; c += 2) {
    SCAN_CHUNK(c, 0)
    store_chunk(1, ra);
    if (c + 3 < NCH) load_chunk(c + 3, ra);
    vbar<true>(hb);
    SCAN_CHUNK(c + 1, 1)
    if (c + 2 < NCH) store_chunk(0, rb);
    if (c + 4 < NCH) load_chunk(c + 4, rb);
    vbar<true>(hb);
  }
#undef SCAN_CHUNK
  __builtin_amdgcn_s_setprio(0);
#undef ROWBASE
#undef SCAN_BP
#undef LDSTEP
#undef load_chunk
#undef store_chunk
}

__device__ void readout_phase(const P& p, int layer, int nrows) {
  const int tid = otid();
  for (int row = obid(); row < nrows; row += VG) {
#pragma unroll
    for (int j = 0; j < 3; ++j) {
      const int c = tid + NT * j;
      float y = p.YB[(size_t)row * DR + c] + p.YB[((size_t)NTOK + row) * DR + c];
      float mu = wave_sum(y) * (1.f / 64.f);
      float dlt = y - mu;
      float var = wave_sum(dlt * dlt) * (1.f / 64.f);
      float yn = dlt * rsqrtf(var + 64e-5f) * p.ln_g[layer * DR + c] + p.ln_b[layer * DR + c];
      const size_t gi = (((size_t)(row >> 4) * 12 + (c >> 6)) * 4 + ((c >> 4) & 3)) * 256 + (row & 15) * 16 + (c & 15);
      const size_t vi = ((size_t)(row >> 4) * 12 + (c >> 6)) * 3072 + 2048 + ((c >> 4) & 3) * 256 + (row & 15) * 16 + (c & 15);
      float o = (yn + p.SHR[vi] * p.BON[(size_t)row * 12 + (c >> 6)]) * __uint_as_float((unsigned)((const bf16_t*)p.GB)[gi] << 16);
      p.HB[(size_t)row * D + c] = f2bf(o);
    }
  }
}

#define XB_TMO      128
#define XB_XCNT(j)  (256  + 64 * (j))
#define XB_XSUB(j)  (1280 + 64 * (j))
#define XB_XGEN(j)  (2304 + 64 * (j))
#define XB_TOP      3328
#define XB_TOPGEN   3392
#define XCD_BAR_WORDS 3456
#define XB_SPIN_CAP (1u << 22)
#define LAS __attribute__((address_space(3)))
__device__ __forceinline__ unsigned xb_ld(unsigned* p)              { return __hip_atomic_load(p, __ATOMIC_RELAXED, __HIP_MEMORY_SCOPE_AGENT); }
__device__ __forceinline__ unsigned xb_add(unsigned* p, unsigned v) { return __hip_atomic_fetch_add(p, v, __ATOMIC_RELAXED, __HIP_MEMORY_SCOPE_AGENT); }
__device__ __forceinline__ unsigned xb_xcc_id() { return (unsigned)__builtin_amdgcn_s_getreg((3 << 11) | 20) & 0xFu; }
#define XB_SPIN(cond, bar) do { unsigned _sp = 0; while (cond) { __builtin_amdgcn_s_sleep(1); \
    if ((++_sp & 255u) == 0u) { if (xb_ld(&(bar)[XB_TMO])) break; if (_sp > XB_SPIN_CAP) { atomicAdd(&(bar)[XB_TMO], 1u); break; } } } } while (0)
struct XcdBarrier { unsigned* bar; unsigned x; volatile LAS unsigned* st; };
__device__ __forceinline__ XcdBarrier xcd_barrier_post(unsigned* bar, volatile LAS unsigned* st) {
  XcdBarrier b; b.bar = bar; b.x = xb_xcc_id(); b.st = st;
  if (threadIdx.x == 0) (void)xb_add(&bar[XB_XCNT(b.x)], 1u);
  return b;
}
__device__ __forceinline__ void xcd_barrier_complete(unsigned* bar, unsigned x, unsigned& nloc, unsigned& nx) {
  const unsigned G = gridDim.x * gridDim.y * gridDim.z;
  unsigned sum, cnt, mine, sp = 0u;
  for (;;) {
    sum = 0u; cnt = 0u; mine = 0u;
#pragma unroll
    for (unsigned j = 0; j < 16; ++j) { const unsigned c = xb_ld(&bar[XB_XCNT(j)]); sum += c; cnt += (c > 0u) ? 1u : 0u; mine = (j == x) ? c : mine; }
    if (sum == G) break;
    __builtin_amdgcn_s_sleep(1);
    if ((++sp & 255u) == 0u) { if (xb_ld(&bar[XB_TMO])) break; if (sp > XB_SPIN_CAP) { atomicAdd(&bar[XB_TMO], 1u); break; } }
  }
  nloc = mine > 0u ? mine : 1u; nx = cnt > 0u ? cnt : 1u;
}
__device__ __forceinline__ void xcd_barrier(const XcdBarrier& b) {
  asm volatile("s_waitcnt vmcnt(0)" ::: "memory");
  __syncthreads();
  if (threadIdx.x == 0) {
    unsigned* bar = b.bar;
    __builtin_amdgcn_s_waitcnt(0);
    unsigned nloc = b.st[0], nx = b.st[1];
    if (nloc == 0u) { xcd_barrier_complete(bar, b.x, nloc, nx); b.st[0] = nloc; b.st[1] = nx; }
    const unsigned old = xb_add(&bar[XB_XSUB(b.x)], 1u);
    const unsigned gen = old / nloc;
    if (old + 1u == (gen + 1u) * nloc) {
      __builtin_amdgcn_fence(__ATOMIC_RELEASE, "agent");
      asm volatile("s_waitcnt vmcnt(0)" ::: "memory");
      const unsigned og = xb_add(&bar[XB_TOP], 1u);
      const unsigned tg = og / nx;
      if (og + 1u == (tg + 1u) * nx) xb_add(&bar[XB_TOPGEN], 1u);
      else XB_SPIN(xb_ld(&bar[XB_TOPGEN]) == tg, bar);
      __builtin_amdgcn_fence(__ATOMIC_ACQUIRE, "agent");
      xb_add(&bar[XB_XGEN(b.x)], 1u);
      asm volatile("s_waitcnt vmcnt(0)" ::: "memory");
    } else {
      XB_SPIN(xb_ld(&bar[XB_XGEN(b.x)]) == gen, bar);
      __builtin_amdgcn_fence(__ATOMIC_ACQUIRE, "agent");
      asm volatile("s_waitcnt vmcnt(0)" ::: "memory");
    }
  }
  __syncthreads();
}

__global__ void __launch_bounds__(NTR, 2) fwd_megakernel(P p) {
  extern __shared__ __attribute__((aligned(16))) char lds[];
  cg::grid_group grid = cg::this_grid();
  volatile LAS unsigned* st = (volatile LAS unsigned*)(lds + 131072);
#define ldsh (lds + (rtid() >> 8) * 65536)
  if (threadIdx.x < 4) st[threadIdx.x] = 0u;
  __syncthreads();
  (void)xcd_barrier_post(p.bar, st);
  if (gridDim.x == 0x7fffffffu) grid.sync();
#define GSYNC() do { XcdBarrier b_; b_.bar = p.bar; b_.x = xb_xcc_id(); b_.st = (volatile LAS unsigned*)(lds + 131072); xcd_barrier(b_); } while (0)
  phase_a(p, ldsh);
  GSYNC();
  phase_b(p);
  GSYNC();
#pragma unroll 1
  for (int l = 0; l < 2; ++l) {
    const int M2 = l == 0 ? NTOK : NLAT;
    norm_phase(p, l, 0, NTOK);
    GSYNC();
    gemm_phase<EPI_IN>(p, l, p.HB, p.wt_in + (size_t)l * DINP * D, NTOK, DINP, D, lds);
    GSYNC();
    mix_phase(p, l, ldsh);
    GSYNC();
    scan_phase(p, l, ldsh, (volatile LAS unsigned*)(lds + 131072) + 8);
    GSYNC();
    readout_phase(p, l, M2);
    GSYNC();
    gemm_phase<EPI_OUT>(p, l, p.HB, p.wt_out + (size_t)l * D * D, M2, D, D, lds, NLAT, 8, p.Z);
    GSYNC();
    norm_phase(p, l, 1, M2);
    GSYNC();
    gemm_phase<EPI_GU>(p, l, p.HB, p.wt_gu + (size_t)l * 2 * FH * D, M2, 2 * FH, D, lds);
    GSYNC();
    gemm_phase<EPI_DOWN>(p, l, p.HID, p.wt_down + (size_t)l * D * FH, M2, D, FH, lds, NLAT, 11, p.Z + (size_t)8 * NCTXR * D);
    GSYNC();
  }
  final_phase(p);
}

extern "C" void kernel_launch(void* const* d_in, const int* in_sizes, int n_in, void* d_out, int out_size, void* d_ws, size_t ws_size,
                              hipStream_t stream) {
  static int grid_blocks = 0;
  if (!grid_blocks) {
    int dev = 0, cus = 0, per_cu = 0;
    hipGetDevice(&dev);
    hipDeviceGetAttribute(&cus, hipDeviceAttributeMultiprocessorCount, dev);
    hipFuncSetAttribute((const void*)fwd_megakernel, hipFuncAttributeMaxDynamicSharedMemorySize, LDS_BYTES);
    hipOccupancyMaxActiveBlocksPerMultiprocessor(&per_cu, fwd_megakernel, NTR, LDS_BYTES);
    if (per_cu > 1) per_cu = 1;
    if (per_cu < 1) per_cu = 1;
    grid_blocks = cus * per_cu;
  }
  P p{};
  const float* const* in = (const float* const*)d_in;
  p.x = in[0]; p.c = in[1]; p.ctx = in[2]; p.c_ctx = in[3]; p.ada_w = in[4]; p.ada_b = in[5]; p.nmg = in[6]; p.nfg = in[7]; p.w_in = in[8];
  p.mu = in[9]; p.w0 = in[10]; p.w_up = in[11]; p.a0 = in[12]; p.a_up = in[13]; p.g_up = in[14]; p.k_k = in[15]; p.k_a = in[16]; p.r_k = in[17];
  p.ln_g = in[18]; p.ln_b = in[19]; p.pool_w = in[20]; p.pool_scale = in[21]; p.sink = in[22]; p.w_out = in[23]; p.w_gu = in[24]; p.w_down = in[25];
  p.fng = in[26];
  p.out = (float*)d_out;
  char* w = (char*)d_ws; size_t off = 0;
  auto take = [&](size_t bytes) { char* r = w + off; off += (bytes + 255) & ~(size_t)255; return r; };
  p.wt_in = (bf16_t*)take((size_t)2 * DINP * D * 2);
  p.wt_out = (bf16_t*)take((size_t)2 * D * D * 2);
  p.wt_gu = (bf16_t*)take((size_t)2 * 2 * FH * D * 2);
  p.wt_down = (bf16_t*)take((size_t)2 * D * FH * 2);
  p.X = (float*)take((size_t)NTOK * D * 4);
  p.HB = (bf16_t*)take((size_t)NTOK * D * 2);
  p.Z = (float*)take((size_t)NTOK * ZC * 4);
  p.QB = (bf16_t*)take((size_t)NTOK * DR * 2);
  p.KB = (bf16_t*)take((size_t)NTOK * 256 * 2);
  p.VT = (bf16_t*)take((size_t)2 * 4 * 64 * VTS * 2);
  p.SOPS = (float*)take((size_t)2 * NTOK * 12 * 192 * 4);
  p.SHR = (float*)take((size_t)NTOK * 12 * 192 * 4);
  p.GB = (float*)take((size_t)NTOK * DR * 4);
  p.BON = (float*)take((size_t)NTOK * DR * 4);
  p.YB = (float*)take((size_t)2 * NTOK * DR * 4);
  p.MOD = (float*)take((size_t)2 * 3 * 6 * D * 4);
  p.ROPE = (float*)take(2048 * 4);
  p.bar = (unsigned*)take(XCD_BAR_WORDS * 4);
  p.WLR = (bf16_t*)take((size_t)2 * DR * 384 * 2);
  p.PWF = (bf16_t*)take((size_t)2 * 4 * 128 * 128 * 2);
  p.HID = (bf16_t*)p.SOPS;
  p.MODP = p.SOPS;
  if (off > ws_size) { fprintf(stderr, "workspace too small: need %zu have %zu\n", off, ws_size); return; }
  hipMemsetAsync(p.bar, 0, XCD_BAR_WORDS * 4, stream);
  void* args[] = {&p};
  hipError_t e = hipLaunchCooperativeKernel((const void*)fwd_megakernel, dim3(grid_blocks), dim3(NTR), args, LDS_BYTES, stream);
  if (e != hipSuccess) fprintf(stderr, "cooperative launch failed: %s (grid %d)\n", hipGetErrorString(e), grid_blocks);
}
```

```cpp
#include <hip/hip_runtime.h>
#include <hip/hip_cooperative_groups.h>
#include <cstdint>
#include <cstdio>
namespace cg = cooperative_groups;

typedef unsigned short bf16_t;
typedef short bf16x8 __attribute__((ext_vector_type(8)));
typedef float f32x4 __attribute__((ext_vector_type(4)));

constexpr int D = 2048, T = 4096, CTX = 256, NLAT = 8192, NCTXR = 512, NTOK = 8704;
constexpr int DIN = 4480, ZC = 3200, FH = 5632;
constexpr int DR = 768;
constexpr int VTS = T + CTX;
constexpr int NT = 256;
constexpr int NTR = 512;
constexpr int DINP = 4608;
constexpr int LDS_BYTES = 131072 + 256;

struct P {
  const float *x, *c, *ctx, *c_ctx, *ada_w, *ada_b, *nmg, *nfg, *w_in, *mu, *w0, *w_up, *a0, *a_up, *g_up, *k_k, *k_a, *r_k,
      *ln_g, *ln_b, *pool_w, *pool_scale, *sink, *w_out, *w_gu, *w_down, *fng;
  float* out;
  bf16_t *wt_in, *wt_out, *wt_gu, *wt_down;
  float* X; bf16_t* HB; float* Z; bf16_t *QB, *KB, *VT; float *SOPS, *SHR, *GB, *BON, *YB, *MOD, *MODP, *ROPE; bf16_t* HID; unsigned* bar; bf16_t* WLR; bf16_t* PWF;
};

__device__ __forceinline__ int otid() { int t = threadIdx.x & 255; asm volatile("" : "+v"(t)); return t; }
__device__ __forceinline__ int obid() { int t = blockIdx.x * 2 + __builtin_amdgcn_readfirstlane(threadIdx.x >> 8); asm volatile("" : "+s"(t)); return t; }
__device__ __forceinline__ int rtid() { int t = threadIdx.x; asm volatile("" : "+v"(t)); return t; }
__device__ __forceinline__ int rbid() { int t = blockIdx.x; asm volatile("" : "+s"(t)); return t; }
#define VG ((int)(gridDim.x * 2))
#define UNIFORM_TASKS(it, n, first, stride, NBAR, CALL) for (int _b0 = 0; _b0 < (n); _b0 += (stride)) { const int it = _b0 + (first); \
    if (it < (n)) { CALL; } else { for (int _k = 0; _k < (NBAR); ++_k) __syncthreads(); } }
__device__ __forceinline__ unsigned pk_bf16(float lo, float hi) {
  unsigned r; asm("v_cvt_pk_bf16_f32 %0, %1, %2" : "=v"(r) : "v"(lo), "v"(hi)); return r;
}
__device__ __forceinline__ bf16_t f2bf(float f) { return (bf16_t)(pk_bf16(f, 0.f) & 0xffffu); }
__device__ __forceinline__ float wave_sum(float v) {
#pragma unroll
  for (int o = 32; o >= 1; o >>= 1) v += __shfl_xor(v, o);
  return v;
}
template <int CTRL> __device__ __forceinline__ float dpp_add(float x) {
  int y = __builtin_amdgcn_update_dpp(0, __float_as_int(x), CTRL, 0xF, 0xF, false);
  return x + __int_as_float(y);
}
__device__ __forceinline__ float reduce16(float x) {
  x = dpp_add<0x128>(x);
  x = dpp_add<0x124>(x);
  x = dpp_add<0x122>(x);
  x = dpp_add<0x121>(x);
  return x;
}
__device__ __forceinline__ float sigmoidf_(float x) { return __builtin_amdgcn_rcpf(1.f + __expf(-x)); }
__device__ __forceinline__ size_t zidx(int row, int col) { return ((((size_t)(row >> 4) * (ZC / 16) + (col >> 4)) * 16 + (row & 15)) << 4) + (col & 15); }
__device__ __forceinline__ void kv_tile_of_row(int row, int& s, int& tile, int& u) {
  if (row < NLAT) { s = row >> 12; const int t = row & (T - 1); tile = t >> 5; u = t & 31; }
  else { const int rc = row - NLAT; s = rc >> 8; tile = 128 + ((rc & 255) >> 5); u = rc & 31; }
}
__device__ __forceinline__ int mod_vec(int row) { return row < NLAT ? (row >> 12) : 2; }
__device__ __forceinline__ const float* resid_in(const P& p, int row) {
  return row < NLAT ? p.x + (size_t)row * D : p.ctx + (size_t)(row - NLAT) * D;
}

struct HalfBar { volatile __attribute__((address_space(3))) unsigned* cnt; unsigned gen; };
template <bool SOFT> __device__ __forceinline__ void vbar(HalfBar& hb) {
  if (!SOFT) { __syncthreads(); return; }
  asm volatile("s_waitcnt lgkmcnt(0)" ::: "memory");
  hb.gen += 4u;
  if ((threadIdx.x & 63) == 0) {
    __hip_atomic_fetch_add((__attribute__((address_space(3))) unsigned*)hb.cnt, 1u, __ATOMIC_RELEASE, __HIP_MEMORY_SCOPE_WORKGROUP);
    while (__hip_atomic_load((__attribute__((address_space(3))) unsigned*)hb.cnt, __ATOMIC_ACQUIRE, __HIP_MEMORY_SCOPE_WORKGROUP) < hb.gen) __builtin_amdgcn_s_sleep(1);
  }
  asm volatile("s_waitcnt lgkmcnt(0)" ::: "memory");
}

template <bool SOFT>
__device__ void convert_tile(const float* __restrict__ W, int K, int N, bf16_t* __restrict__ Bt, int gu, int tile, float* s, HalfBar& hb) {
  const int tid = otid();
  const int nkb = K >> 6;
  const int kb = tile % nkb, nb = tile / nkb;
#pragma unroll
  for (int i = 0; i < 4; ++i) {
    int idx = tid + NT * i; int kk = idx >> 4, n4 = idx & 15;
    const f32x4 v4 = __builtin_nontemporal_load((const f32x4*)(W + (size_t)(kb * 64 + kk) * N + nb * 64 + n4 * 4));
    float4 v; v.x = v4[0]; v.y = v4[1]; v.z = v4[2]; v.w = v4[3];
    s[(n4 * 4 + 0) * 65 + kk] = v.x; s[(n4 * 4 + 1) * 65 + kk] = v.y; s[(n4 * 4 + 2) * 65 + kk] = v.z; s[(n4 * 4 + 3) * 65 + kk] = v.w;
  }
  vbar<SOFT>(hb);
#pragma unroll
  for (int i = 0; i < 2; ++i) {
    int idx = tid + NT * i; int n = idx >> 3, k8 = idx & 7;
    const float* sp = s + n * 65 + k8 * 8;
    uint4 o; o.x = pk_bf16(sp[0], sp[1]); o.y = pk_bf16(sp[2], sp[3]); o.z = pk_bf16(sp[4], sp[5]); o.w = pk_bf16(sp[6], sp[7]);
    int nn = nb * 64 + n;
    if (gu) { if (nn < FH) nn = (nn >> 4) * 32 + (nn & 15); else { int h = nn - FH; nn = (h >> 4) * 32 + 16 + (h & 15); } }
    *(uint4*)(Bt + (size_t)nn * K + kb * 64 + k8 * 8) = o;
  }
  vbar<SOFT>(hb);
}

__device__ void phase_a(const P& p, char* lds) {
  float* s = (float*)lds;
  HalfBar hb0{nullptr, 0u};
  const int tid = otid();
  UNIFORM_TASKS(it, 32 * 70, obid(), VG, 2, convert_tile<false>(p.w_in, D, DIN, p.wt_in, 0, it, s, hb0))
  for (int b0 = 0; b0 < 2 * 12 * 32; b0 += VG) {
    const int it = b0 + obid();
    if (it >= 2 * 12 * 32) { __syncthreads(); __syncthreads(); continue; }
    int l = it / 384, r = it % 384, cb = r / 32, ks = r % 32;
    if (tid < 192) {
      int v = tid >> 6, k = ks * 64 + (tid & 63);
      float cv = v == 0 ? p.c[k] : (v == 1 ? p.c[D + k] : p.c_ctx[k]);
      s[tid] = cv * sigmoidf_(cv);
    }
    __syncthreads();
    float4 a0 = {0, 0, 0, 0}, a1 = a0, a2 = a0;
    const float* wp = p.ada_w + ((size_t)l * D + ks * 64) * (6 * D) + cb * 1024 + tid * 4;
#pragma unroll 8
    for (int kk = 0; kk < 64; ++kk) {
      const f32x4 w4 = __builtin_nontemporal_load((const f32x4*)(wp + (size_t)kk * (6 * D)));
      float4 w; w.x = w4[0]; w.y = w4[1]; w.z = w4[2]; w.w = w4[3];
      float s0 = s[kk], s1 = s[64 + kk], s2 = s[128 + kk];
      a0.x += s0 * w.x; a0.y += s0 * w.y; a0.z += s0 * w.z; a0.w += s0 * w.w;
      a1.x += s1 * w.x; a1.y += s1 * w.y; a1.z += s1 * w.z; a1.w += s1 * w.w;
      a2.x += s2 * w.x; a2.y += s2 * w.y; a2.z += s2 * w.z; a2.w += s2 * w.w;
    }
    float* o = p.MODP + ((size_t)(ks * 2 + l) * 3) * (6 * D) + cb * 1024 + tid * 4;
    *(float4*)(o) = a0; *(float4*)(o + 6 * D) = a1; *(float4*)(o + 12 * D) = a2;
    __syncthreads();
  }
  for (int idx = obid() * NT + tid; idx < 2 * DR * 48; idx += VG * NT) {
    const int l = idx / (DR * 48), rem = idx % (DR * 48), c = rem / 48, k0 = (rem % 48) * 8;
    const float* srcw = k0 < 128 ? p.w_up : (k0 < 256 ? p.a_up : p.g_up);
    const int kb = k0 < 128 ? k0 : (k0 < 256 ? k0 - 128 : k0 - 256);
    float v[8];
#pragma unroll
    for (int j = 0; j < 8; ++j) v[j] = srcw[((size_t)l * 128 + kb + j) * DR + c];
    uint4 o; o.x = pk_bf16(v[0], v[1]); o.y = pk_bf16(v[2], v[3]); o.z = pk_bf16(v[4], v[5]); o.w = pk_bf16(v[6], v[7]);
    *(uint4*)(p.WLR + ((((size_t)(l * 12 + (c >> 6)) * 4 + ((c >> 4) & 3)) * 12 + (k0 >> 5)) * 64 + ((k0 >> 3) & 3) * 16 + (c & 15)) * 8) = o;
  }
  for (int idx = obid() * NT + tid; idx < 2 * 4 * 8 * 4 * 64; idx += VG * NT) {
    const int ln = idx & 63, ks = (idx >> 6) & 3, nt = (idx >> 8) & 7, lg = idx >> 11;
    const int d = nt * 16 + (ln & 15), c0 = ks * 32 + (ln >> 4) * 8;
    float v[8];
#pragma unroll
    for (int j = 0; j < 8; ++j) v[j] = p.pool_w[((size_t)lg * 128 + c0 + j) * 128 + d];
    uint4 o; o.x = pk_bf16(v[0], v[1]); o.y = pk_bf16(v[2], v[3]); o.z = pk_bf16(v[4], v[5]); o.w = pk_bf16(v[6], v[7]);
    *(uint4*)(p.PWF + (size_t)idx * 8) = o;
  }
  if (obid() == VG - 1) {
    for (int e = tid; e < 1024; e += NT) {
      int pos = e >> 4, i = e & 15;
      float inv = (float)exp2(-(double)i / 16.0 * 13.287712379549449);
      float angf = (float)pos * inv;
      double a = (double)angf;
      double n = rint(a * 0.6366197723675814);
      double r = a - n * 1.5707963267948966;
      double r2 = r * r;
      double sn = r * (1.0 + r2 * (-1.0 / 6 + r2 * (1.0 / 120 + r2 * (-1.0 / 5040 + r2 * (1.0 / 362880 + r2 * (-1.0 / 39916800 + r2 * (1.0 / 6227020800.0)))))));
      double cs = 1.0 + r2 * (-0.5 + r2 * (1.0 / 24 + r2 * (-1.0 / 720 + r2 * (1.0 / 40320 + r2 * (-1.0 / 3628800 + r2 * (1.0 / 479001600.0 + r2 * (-1.0 / 87178291200.0)))))));
      int qd = ((int)n) & 3;
      double c2 = qd == 0 ? cs : (qd == 1 ? -sn : (qd == 2 ? -cs : sn));
      double s2 = qd == 0 ? sn : (qd == 1 ? cs : (qd == 2 ? -sn : -cs));
      p.ROPE[e] = (float)c2; p.ROPE[1024 + e] = (float)s2;
    }
  }
}

__device__ void phase_b(const P& p) {
  for (int idx = obid() * NT + otid(); idx < 2 * 3 * 6 * D; idx += VG * NT) {
    int n = idx % (6 * D), lv = idx / (6 * D), l = lv / 3, v = lv % 3;
    float sum = p.ada_b[l * 6 * D + n];
#pragma unroll 8
    for (int ks = 0; ks < 32; ++ks) sum += p.MODP[((size_t)(ks * 2 + l) * 3 + v) * (6 * D) + n];
    p.MOD[idx] = sum;
  }
}

__device__ void norm_phase(const P& p, int layer, int which, int nrows) {
  const int lane = otid() & 63, wave = otid() >> 6;
  const float* g = (which ? p.nfg : p.nmg) + layer * D;
  const int NW = VG * 4, gw = obid() * 4 + wave;
  const int nlat = min(nrows, NLAT), rpw = (nlat + NW - 1) / NW;
  const int nctx_w = nrows > NLAT ? (nrows - NLAT - gw + NW - 1) / NW : 0;
  float4 mult[8], shv[8]; int cv = -1;
  for (int k = 0; k < rpw + (nctx_w > 0 ? nctx_w : 0); ++k) {
    int row;
    if (k < rpw) { row = gw * rpw + k; if (row >= nlat) continue; }
    else { row = NLAT + gw + (k - rpw) * NW; if (row >= nrows) continue; }
    const int mv = mod_vec(row);
    if (mv != cv) {
      cv = mv;
      const float* md = p.MOD + ((size_t)(layer * 3 + mv) * 6 + (which ? 3 : 0)) * D;
#pragma unroll
      for (int i = 0; i < 8; ++i) {
        const int col = i * 256 + lane * 4;
        const float4 gg = *(const float4*)(g + col), sh = *(const float4*)(md + col), sc = *(const float4*)(md + D + col);
        mult[i].x = gg.x * (1.f + sc.x); mult[i].y = gg.y * (1.f + sc.y); mult[i].z = gg.z * (1.f + sc.z); mult[i].w = gg.w * (1.f + sc.w);
        shv[i] = sh;
      }
    }
    const float* src = (layer == 0 && which == 0) ? resid_in(p, row) : p.X + (size_t)row * D;
    float4 v[8]; float ss = 0.f;
    const bool foldO = (layer == 0 && which == 1 && row >= NLAT), foldD = (layer == 1 && which == 0 && row >= NLAT);
    if (foldO) src = resid_in(p, row);
#pragma unroll
    for (int i = 0; i < 8; ++i) {
      const int col = i * 256 + lane * 4;
      v[i] = *(const float4*)(src + col);
      if (foldO || foldD) {
        const float* sl = p.Z + (foldD ? (size_t)8 * NCTXR * D : 0) + (size_t)(row - NLAT) * D + col;
        const int ns = foldD ? 11 : 8;
        float4 a = *(const float4*)(sl);
        for (int s = 1; s < ns; ++s) { const float4 b = *(const float4*)(sl + (size_t)s * NCTXR * D); a.x += b.x; a.y += b.y; a.z += b.z; a.w += b.w; }
        const float4 gt = *(const float4*)(p.MOD + ((size_t)(0 * 3 + 2) * 6 + (foldO ? 2 : 5)) * D + col);
        v[i].x += gt.x * a.x; v[i].y += gt.y * a.y; v[i].z += gt.z * a.z; v[i].w += gt.w * a.w;
        if (foldO) *(float4*)(p.X + (size_t)row * D + col) = v[i];
      }
      ss += v[i].x * v[i].x + v[i].y * v[i].y + v[i].z * v[i].z + v[i].w * v[i].w;
    }
    ss = wave_sum(ss);
    const float rinv = rsqrtf(ss * (1.f / D) + 1e-6f);
#pragma unroll
    for (int i = 0; i < 8; ++i) {
      const int col = i * 256 + lane * 4;
      const float y0 = v[i].x * rinv * mult[i].x + shv[i].x, y1 = v[i].y * rinv * mult[i].y + shv[i].y;
      const float y2 = v[i].z * rinv * mult[i].z + shv[i].z, y3 = v[i].w * rinv * mult[i].w + shv[i].w;
      uint2 o; o.x = pk_bf16(y0, y1); o.y = pk_bf16(y2, y3);
      *(uint2*)(p.HB + (size_t)row * D + col) = o;
    }
  }
}

__device__ void final_phase(const P& p) {
  const int lane = otid() & 63, wave = otid() >> 6;
  float4 gf[8];
#pragma unroll
  for (int i = 0; i < 8; ++i) gf[i] = *(const float4*)(p.fng + i * 256 + lane * 4);
  for (int row = obid() * 4 + wave; row < NLAT; row += VG * 4) {
    const float* src = p.X + (size_t)row * D;
    float4 v[8]; float ss = 0.f;
#pragma unroll
    for (int i = 0; i < 8; ++i) { v[i] = *(const float4*)(src + i * 256 + lane * 4); ss += v[i].x * v[i].x + v[i].y * v[i].y + v[i].z * v[i].z + v[i].w * v[i].w; }
    ss = wave_sum(ss);
    float rinv = rsqrtf(ss * (1.f / D) + 1e-6f);
#pragma unroll
    for (int i = 0; i < 8; ++i) {
      int col = i * 256 + lane * 4;
      const float4 gg = gf[i];
      float4 o = {v[i].x * rinv * gg.x, v[i].y * rinv * gg.y, v[i].z * rinv * gg.z, v[i].w * rinv * gg.w};
      *(float4*)(p.out + (size_t)row * D + col) = o;
    }
  }
}

enum { EPI_IN = 0, EPI_OUT = 1, EPI_GU = 2, EPI_DOWN = 3 };
namespace g8 {
constexpr int BM = 256, BK = 64, HALF = 128, HTB = HALF * BK * 2, NXCD = 8, WGM = 4;
__device__ __forceinline__ int lds_byte(int r, int c) { const int st = (r >> 4) * 2 + (c >> 5), rr = r & 15, cc = c & 31, ob = rr * 64 + cc * 2; return st * 1024 + (ob ^ (((ob >> 9) & 1) << 5)); }
__device__ __forceinline__ void stage_rc(int b, int& R, int& C) { const int st = b / 1024, sb = b % 1024, swz = sb ^ (((sb >> 9) & 1) << 5); R = (st >> 1) * 16 + swz / 64; C = (st & 1) * 32 + (swz % 64) / 2; }
}

template <int EPI>
__device__ __forceinline__ void epi8(const P& p, int layer, const f32x4 (&acc)[2][2][4][2], int brow, int bcol, int wr, int wc, int fr, int fq) {
#pragma unroll
  for (int ai = 0; ai < 2; ++ai)
#pragma unroll
    for (int bj = 0; bj < 2; ++bj) {
      const int cb = (bcol >> 7) + bj;
      const int col = bcol + bj * 128 + wc * 32 + fq * 4;
      const int row0 = brow + ai * 128 + wr * 64 + fr;
      if (EPI == EPI_IN) {
        if (cb < 25) {
#pragma unroll
          for (int m = 0; m < 4; ++m) {
            float* zp = p.Z + zidx(row0 + m * 16, col);
            *(f32x4*)(zp) = acc[ai][bj][m][0]; *(f32x4*)(zp + 256) = acc[ai][bj][m][1];
          }
        } else if (cb < 33) {
          const bool isq = cb < 31;
          const float scl = isq ? 0.125f : 1.0f;
          bf16_t* dst = isq ? p.QB : p.KB;
          const int ld = isq ? DR : 256;
          const int cc = col - (isq ? 3200 : 3968);
          const int second = wc & 1;
#pragma unroll
          for (int m = 0; m < 4; ++m) {
            const int row = row0 + m * 16;
            f32x4 c1 = {1.f, 1.f, 1.f, 1.f}, s1 = {0.f, 0.f, 0.f, 0.f};
            if (row < NLAT) {
              const int t = row & (T - 1), pos = second ? (t & 63) : (t >> 6);
              c1 = *(const f32x4*)(p.ROPE + pos * 16 + fq * 4); s1 = *(const f32x4*)(p.ROPE + 1024 + pos * 16 + fq * 4);
            }
            const f32x4 x0 = acc[ai][bj][m][0], x1 = acc[ai][bj][m][1];
            const f32x4 o0 = (x0 * c1 - x1 * s1) * scl, o1 = (x1 * c1 + x0 * s1) * scl;
            uint2 w0, w1;
            w0.x = pk_bf16(o0[0], o0[1]); w0.y = pk_bf16(o0[2], o0[3]);
            w1.x = pk_bf16(o1[0], o1[1]); w1.y = pk_bf16(o1[2], o1[3]);
            if (isq) {
              bf16_t* dp = dst + (size_t)row * ld + cc;
              *(uint2*)(dp) = w0; *(uint2*)(dp + 16) = w1;
            } else {
              int s, tile, u; kv_tile_of_row(row, s, tile, u);
              const int hk = cc >> 6, d0 = cc & 63;
              const int kfr = (u >> 3) * 4 + (u & 3), kk = (u >> 2) & 1;
              bf16_t* kb = p.KB + ((size_t)(((s * 4 + hk) * 136 + tile) * 4 + kk * 2 + (d0 >> 5)) * 64 + kfr) * 8;
              *(uint2*)(kb + ((d0 >> 3) & 3) * 128 + (d0 & 7)) = w0;
              *(uint2*)(kb + (((d0 + 16) >> 3) & 3) * 128 + (d0 & 7)) = w1;
            }
          }
        } else if (cb < 35) {
          const int cv = col - 4224;
#pragma unroll
          for (int m = 0; m < 4; ++m) {
            const int row = row0 + m * 16;
            int s, tile, u; kv_tile_of_row(row, s, tile, u);
#pragma unroll
            for (int n = 0; n < 2; ++n)
#pragma unroll
              for (int j = 0; j < 4; ++j) {
                const int c2 = cv + n * 16 + j; const int hk = c2 >> 6, dim = c2 & 63;
                p.VT[((size_t)(((s * 4 + hk) * 136 + tile) * 4 + (dim >> 4)) * 64 + (u >> 3) * 16 + (dim & 15)) * 8 + (u & 7)] = f2bf(acc[ai][bj][m][n][j]);
              }
          }
        }
      } else if (EPI == EPI_OUT || EPI == EPI_DOWN) {
#pragma unroll
        for (int m = 0; m < 4; ++m) {
          const int row = row0 + m * 16;
          const float* gt = p.MOD + ((size_t)(layer * 3 + mod_vec(row)) * 6 + (EPI == EPI_OUT ? 2 : 5)) * D;
          const float* rs = (EPI == EPI_OUT && layer == 0) ? resid_in(p, row) : p.X + (size_t)row * D;
#pragma unroll
          for (int n = 0; n < 2; ++n) {
            const int c2 = col + n * 16;
            const f32x4 r = *(const f32x4*)(rs + c2), g = *(const f32x4*)(gt + c2);
            *(f32x4*)(p.X + (size_t)row * D + c2) = r + g * acc[ai][bj][m][n];
          }
        }
      } else {
        const int hc = ((bcol + bj * 128 + wc * 32) >> 5) * 16 + fq * 4;
#pragma unroll
        for (int m = 0; m < 4; ++m) {
          const f32x4 g = acc[ai][bj][m][0], u = acc[ai][bj][m][1];
          const float h0 = g[0] * sigmoidf_(g[0]) * u[0], h1 = g[1] * sigmoidf_(g[1]) * u[1], h2 = g[2] * sigmoidf_(g[2]) * u[2], h3 = g[3] * sigmoidf_(g[3]) * u[3];
          uint2 w; w.x = pk_bf16(h0, h1); w.y = pk_bf16(h2, h3);
          *(uint2*)(p.HID + (size_t)(row0 + m * 16) * FH + hc) = w;
        }
      }
    }
}

template <int EPI>
__device__ void gemm_phase(const P& p, int layer, const bf16_t* __restrict__ A0, const bf16_t* __restrict__ Bt0, int M, int N, int K, char* lds,
                           int Mfull = 1 << 30, int nsl = 1, float* slab = nullptr) {
  using namespace g8;
  const int tid = rtid(), wid = tid >> 6, lane = tid & 63, wr = wid >> 2, wc = wid & 3, fr = lane & 15, fq = lane >> 4;
  const int nMf = min(M, Mfull) / BM, nN = N / BM, nwg = nMf * nN, ntf = K / BK;
  const int nsplit = (M / BM - nMf) * nN * nsl, ntsl = ntf / nsl, nitems = nwg + nsplit;
  unsigned voff;
  { int R, C; stage_rc(tid * 16, R, C); voff = (unsigned)(R * K + C) * 2u; }
  const int aoff = lds_byte(wr * 64 + fr, fq * 8), boff = lds_byte(wc * 32 + fr, fq * 8);
  const unsigned ldsw = (unsigned)__builtin_amdgcn_readfirstlane(wid) * 1024u;
  typedef __attribute__((address_space(3))) unsigned char* lds_p;
  const lds_p ldsl = (lds_p)lds;
  const size_t kstep = (size_t)BK * 2, hstep = (size_t)HALF * K * 2, pstep = (size_t)64 * K * 2;
#define G8_SA(b, h) (((b) * 2 + (h)) * HTB)
#define G8_SB(b, h) ((4 + (b) * 2 + (h)) * HTB)
#define G8_STAGE(bufoff, gp) do { const char* _g = (gp); \
    __builtin_amdgcn_global_load_lds((const unsigned*)(_g + voff), (__attribute__((address_space(3))) unsigned*)(ldsl + (bufoff) + ldsw), 16, 0, 0); \
    __builtin_amdgcn_global_load_lds((const unsigned*)(_g + pstep + voff), (__attribute__((address_space(3))) unsigned*)(ldsl + (bufoff) + ldsw + 8192), 16, 0, 0); } while (0)
#define G8_LDA(dst, b, h) do { _Pragma("unroll") for (int m = 0; m < 4; ++m) _Pragma("unroll") for (int k = 0; k < 2; ++k) dst[m][k] = *(const __attribute__((address_space(3))) bf16x8*)(ldsl + G8_SA(b, h) + aoff + m * 2048 + k * 1024); } while (0)
#define G8_LDB(dst, b, h) do { _Pragma("unroll") for (int n = 0; n < 2; ++n) _Pragma("unroll") for (int k = 0; k < 2; ++k) dst[n][k] = *(const __attribute__((address_space(3))) bf16x8*)(ldsl + G8_SB(b, h) + boff + n * 2048 + k * 1024); } while (0)
#define G8_MMA(ai, bj, At_, Bt_) do { __builtin_amdgcn_s_setprio(1); _Pragma("unroll") for (int m = 0; m < 4; ++m) _Pragma("unroll") for (int n = 0; n < 2; ++n) _Pragma("unroll") for (int k = 0; k < 2; ++k) \
    acc[ai][bj][m][n] = __builtin_amdgcn_mfma_f32_16x16x32_bf16(Bt_[n][k], At_[m][k], acc[ai][bj][m][n], 0, 0, 0); __builtin_amdgcn_s_setprio(0); } while (0)
#define WAIT_V(n) asm volatile("s_waitcnt vmcnt(" #n ")" ::: "memory")
#define WAIT_L(n) asm volatile("s_waitcnt lgkmcnt(" #n ")" ::: "memory")
#define BAR __builtin_amdgcn_s_barrier()
#define SCHED __builtin_amdgcn_sched_barrier(0)
#define G8_DECODE(L_, pm_, pn_, nt_, slice_, cA_, cB_, split_) do { nt_ = ntf; slice_ = 0; split_ = (L_) >= nwg; size_t ko_ = 0; \
    if (!split_) { int wgid = (L_); \
      { const int q = nwg / NXCD, r = nwg % NXCD, xcd = wgid % NXCD, off = wgid / NXCD; wgid = (xcd < r ? xcd * (q + 1) : r * (q + 1) + (xcd - r) * q) + off; } \
      const int nig = WGM * nN, gid = wgid / nig, fm = gid * WGM, gsz = min(nMf - fm, WGM); \
      pm_ = fm + ((wgid % nig) % gsz); pn_ = (wgid % nig) / gsz; \
    } else { const int s_ = (L_) - nwg, tile_ = s_ / nsl; slice_ = s_ % nsl; pm_ = nMf + tile_ / nN; pn_ = tile_ % nN; nt_ = ntsl; ko_ = (size_t)slice_ * ntsl * BK; } \
    cA_ = (const char*)(A0 + (size_t)(pm_) * BM * K + ko_); cB_ = (const char*)(Bt0 + (size_t)(pn_) * BM * K + ko_); } while (0)
  int L = rbid();
  if (L >= nitems) return;
  int pm, pn, nt, slice; const char* cA; const char* cB; bool split;
  G8_DECODE(L, pm, pn, nt, slice, cA, cB, split);
  f32x4 acc[2][2][4][2];
#pragma unroll
  for (int a = 0; a < 2; ++a)
#pragma unroll
    for (int b = 0; b < 2; ++b)
#pragma unroll
      for (int m = 0; m < 4; ++m)
#pragma unroll
        for (int n = 0; n < 2; ++n) acc[a][b][m][n] = (f32x4){0.f, 0.f, 0.f, 0.f};
  bf16x8 At[4][2], B0[2][2], B1[2][2];
  G8_STAGE(G8_SB(0, 0), cB); G8_STAGE(G8_SB(0, 1), cB + hstep); G8_STAGE(G8_SA(0, 0), cA); G8_STAGE(G8_SA(0, 1), cA + hstep);
  if (wr == 1) BAR;
  WAIT_V(2); BAR;
  G8_STAGE(G8_SB(1, 0), cB + kstep); G8_STAGE(G8_SA(1, 0), cA + kstep); G8_STAGE(G8_SB(1, 1), cB + hstep + kstep);
  WAIT_V(6); BAR;
  for (;;) {
    const int Ln = L + (int)gridDim.x; const bool has_next = Ln < nitems;
    const char* nA = cA; const char* nB = cB;
    if (has_next) { int pm2, pn2, nt2, slice2; bool split2; G8_DECODE(Ln, pm2, pn2, nt2, slice2, nA, nB, split2); }
    for (int t = 0; t < nt; t += 2) {
      const bool last = (t == nt - 2);
      const char* a1 = cA + (size_t)(t + 1) * kstep;
      const char* a2 = last ? nA : cA + (size_t)(t + 2) * kstep; const char* b2 = last ? nB : cB + (size_t)(t + 2) * kstep;
      const char* a3 = a2 + kstep; const char* b3 = b2 + kstep;
      G8_LDB(B0, 0, 0); G8_LDB(B1, 0, 1); SCHED; G8_LDA(At, 0, 0); G8_STAGE(G8_SA(1, 1), a1 + hstep);
      WAIT_V(8); WAIT_L(0); BAR; G8_MMA(0, 0, At, B0); G8_MMA(0, 1, At, B1); BAR; SCHED;
      G8_LDA(At, 0, 1); G8_STAGE(G8_SB(0, 0), b2); G8_STAGE(G8_SB(0, 1), b2 + hstep); G8_STAGE(G8_SA(0, 0), a2);
      WAIT_V(8); WAIT_L(0); BAR; G8_MMA(1, 0, At, B0); G8_MMA(1, 1, At, B1); BAR; SCHED;
      G8_LDB(B0, 1, 0); G8_LDB(B1, 1, 1); SCHED; G8_LDA(At, 1, 0); G8_STAGE(G8_SA(0, 1), a2 + hstep);
      WAIT_V(8); WAIT_L(0); BAR; G8_MMA(0, 0, At, B0); G8_MMA(0, 1, At, B1); BAR; SCHED;
      G8_LDA(At, 1, 1); G8_STAGE(G8_SB(1, 0), b3); G8_STAGE(G8_SB(1, 1), b3 + hstep); G8_STAGE(G8_SA(1, 0), a3);
      WAIT_V(8); WAIT_L(0); BAR; G8_MMA(1, 0, At, B0); G8_MMA(1, 1, At, B1); BAR; SCHED;
    }
    if (wr == 0) BAR;
    const int brow = pm * BM, bcol = pn * BM;
    if (!split) epi8<EPI>(p, layer, acc, brow, bcol, wr, wc, fr, fq);
    else {
      float* sp = slab + ((size_t)slice * (M - Mfull) + (brow - Mfull + wr * 64 + fr)) * N + bcol + wc * 32 + fq * 4;
#pragma unroll
      for (int ai = 0; ai < 2; ++ai)
#pragma unroll
        for (int bj = 0; bj < 2; ++bj)
#pragma unroll
          for (int m = 0; m < 4; ++m)
#pragma unroll
            for (int n = 0; n < 2; ++n) *(f32x4*)(sp + (size_t)(ai * 128 + m * 16) * N + bj * 128 + n * 16) = acc[ai][bj][m][n];
    }
    if (!has_next) break;
#pragma unroll
    for (int a = 0; a < 2; ++a)
#pragma unroll
      for (int b = 0; b < 2; ++b)
#pragma unroll
        for (int m = 0; m < 4; ++m)
#pragma unroll
          for (int n = 0; n < 2; ++n) acc[a][b][m][n] = (f32x4){0.f, 0.f, 0.f, 0.f};
    L = Ln;
    G8_DECODE(L, pm, pn, nt, slice, cA, cB, split);
    if (wr == 1) BAR;
  }
  WAIT_V(0);
  BAR;
#undef G8_DECODE
#undef G8_SA
#undef G8_SB
#undef G8_STAGE
#undef G8_LDA
#undef G8_LDB
#undef G8_MMA
#undef WAIT_V
#undef WAIT_L
#undef BAR
#undef SCHED
}

__device__ __forceinline__ void seq_bounds(int row, int& s0, int& s1) {
  if (row < NLAT) { s0 = row & ~(T - 1); s1 = s0 + T; } else { s0 = NLAT + ((row - NLAT) & ~(CTX - 1)); s1 = s0 + CTX; }
}
__device__ __forceinline__ float shifted(const float* __restrict__ Z, const float* __restrict__ mu, int row, bool hp, bool hn, int col) {
  float z = Z[zidx(row, col)];
  float zm = hp ? Z[zidx(row - 1, col)] : 0.f;
  float zp = hn ? Z[zidx(row + 1, col)] : 0.f;
  return z + mu[col] * (0.5f * (zm + zp) - z);
}

__device__ __forceinline__ f32x4 shifted4(const float* __restrict__ Z, const float* __restrict__ mu, int row, bool hp, bool hn, int col) {
  const f32x4 z = *(const f32x4*)(Z + zidx(row, col));
  f32x4 zm = {0.f, 0.f, 0.f, 0.f}, zp = zm;
  if (hp) zm = *(const f32x4*)(Z + zidx(row - 1, col));
  if (hn) zp = *(const f32x4*)(Z + zidx(row + 1, col));
  const f32x4 m = *(const f32x4*)(mu + col);
  return z + m * ((zm + zp) * 0.5f - z);
}

__device__ void prep_task(const P& p, int layer, int task, int hh0, int hh1, char* lds) {
  bf16_t* xs = (bf16_t*)lds;
  const int tid = otid(), lane = tid & 63, wave = tid >> 6, fr = lane & 15, fq = lane >> 4;
  const int row0 = task * 16;
  int s0, s1; seq_bounds(row0, s0, s1);
  const float* mu = p.mu + layer * 2688;
#pragma unroll 2
  for (int i = 0; i < 6; ++i) {
    const int idx = tid + NT * i; const int tok = idx / 96, cc = (idx % 96) * 4;
    const int rw = row0 + tok;
    const f32x4 sv = shifted4(p.Z, mu, rw, rw > s0, rw < s1 - 1, 2304 + cc);
    f32x4 t;
#pragma unroll
    for (int j = 0; j < 4; ++j) {
      float v = sv[j];
      if (cc < 128) v = 1.f - 2.f * __builtin_amdgcn_rcpf(1.f + __expf(2.f * v));
      else if (cc >= 256) v = sigmoidf_(v);
      t[j] = v;
    }
    uint2 w; w.x = pk_bf16(t[0], t[1]); w.y = pk_bf16(t[2], t[3]);
    *(uint2*)(xs + tok * 392 + cc) = w;
  }
  __syncthreads();
  const bf16_t* wl = p.WLR + (size_t)layer * DR * 384;
  const int row = row0 + fr;
  const bool hp = row > s0, hn = row < s1 - 1;
  const float* pw0 = p.w0 + layer * 2 * DR; const float* pa0 = p.a0 + layer * 2 * DR;
  const float* pkk = p.k_k + layer * DR; const float* pka = p.k_a + layer * DR; const float* prk = p.r_k + layer * DR;
#pragma unroll 1
  for (int hh = hh0; hh < hh1; ++hh) {
    const int h = wave + 4 * hh;
    const bf16_t* xp = xs + fr * 392 + fq * 8;
    float ss = 0.f;
#pragma unroll
    for (int ct = 0; ct < 4; ++ct) {
      const int c = h * 64 + ct * 16 + fq * 4;
      const f32x4 kx = shifted4(p.Z, mu, row, hp, hn, DR + c);
      const f32x4 kkw = *(const f32x4*)(pkk + c);
#pragma unroll
      for (int j = 0; j < 4; ++j) { const float kk = kx[j] * kkw[j]; ss += kk * kk; }
    }
    ss += __shfl_xor(ss, 16); ss += __shfl_xor(ss, 32);
    const float kinv = 1.f / fmaxf(sqrtf(ss), 1e-12f);
    float sd = 0.f;
    const size_t tb = (size_t)task * 12 + h;
    float* so0 = p.SOPS + tb * 3072 + fr * 16 + fq * 4;
    float* so1 = p.SOPS + ((size_t)(NTOK / 16) * 12 + tb) * 3072 + fr * 16 + fq * 4;
    float* sh = p.SHR + tb * 3072 + fr * 16 + fq * 4;
    bf16_t* gbp = (bf16_t*)p.GB + tb * 1024 + fr * 16 + fq * 4;
    bf16x8 wcur[12];
    { const bf16_t* wp = wl + ((size_t)(h * 4) * 12 * 64 + lane) * 8;
#pragma unroll
      for (int ks = 0; ks < 12; ++ks) wcur[ks] = *(const bf16x8*)(wp + ks * 512); }
#pragma unroll 1
    for (int ct = 0; ct < 4; ++ct) {
      bf16x8 wnx[12];
      { const bf16_t* wp = wl + ((size_t)(h * 4 + min(ct + 1, 3)) * 12 * 64 + lane) * 8;
#pragma unroll
        for (int ks = 0; ks < 12; ++ks) wnx[ks] = *(const bf16x8*)(wp + ks * 512); }
      asm volatile("" ::: "memory");
      const f32x4 z4 = {0.f, 0.f, 0.f, 0.f};
      f32x4 aw0 = z4, aw1 = z4, aa0 = z4, aa1 = z4, ag = z4;
#pragma unroll
      for (int ks = 0; ks < 12; ++ks) {
        const bf16x8 wf = wcur[ks], xf = *(const bf16x8*)(xp + ks * 32);
        if (ks < 2) aw0 = __builtin_amdgcn_mfma_f32_16x16x32_bf16(wf, xf, aw0, 0, 0, 0);
        else if (ks < 4) aw1 = __builtin_amdgcn_mfma_f32_16x16x32_bf16(wf, xf, aw1, 0, 0, 0);
        else if (ks < 6) aa0 = __builtin_amdgcn_mfma_f32_16x16x32_bf16(wf, xf, aa0, 0, 0, 0);
        else if (ks < 8) aa1 = __builtin_amdgcn_mfma_f32_16x16x32_bf16(wf, xf, aa1, 0, 0, 0);
        else ag = __builtin_amdgcn_mfma_f32_16x16x32_bf16(wf, xf, ag, 0, 0, 0);
      }
      const int c = h * 64 + ct * 16 + fq * 4;
      const f32x4 rr = shifted4(p.Z, mu, row, hp, hn, c), kx = shifted4(p.Z, mu, row, hp, hn, DR + c), vv = shifted4(p.Z, mu, row, hp, hn, 2 * DR + c);
      const f32x4 w00 = *(const f32x4*)(pw0 + c), w01 = *(const f32x4*)(pw0 + DR + c);
      const f32x4 a00 = *(const f32x4*)(pa0 + c), a01 = *(const f32x4*)(pa0 + DR + c);
      const f32x4 kkw = *(const f32x4*)(pkk + c), kaw = *(const f32x4*)(pka + c), rkw = *(const f32x4*)(prk + c);
      f32x4 dec0, dec1, kd0, kd1, bd0, bd1, av;
#pragma unroll
      for (int j = 0; j < 4; ++j) {
        dec0[j] = __expf(-0.6065306597126334f * sigmoidf_(w00[j] + aw0[j]));
        dec1[j] = __expf(-0.6065306597126334f * sigmoidf_(w01[j] + aw1[j]));
        const float ad0 = sigmoidf_(a00[j] + aa0[j]), ad1 = sigmoidf_(a01[j] + aa1[j]);
        const float kk = kx[j] * kkw[j] * kinv;
        kd0[j] = kx[j] * (1.f + (ad0 - 1.f) * kaw[j]); kd1[j] = kx[j] * (1.f + (ad1 - 1.f) * kaw[j]);
        bd0[j] = kk * ad0; bd1[j] = kk * ad1; av[j] = -kk;
        sd += rr[j] * (kd0[j] + kd1[j]) * rkw[j];
      }
      const int o = ct * 256;
      __builtin_nontemporal_store(dec0, (f32x4*)(so0 + o)); __builtin_nontemporal_store(kd0, (f32x4*)(so0 + 1024 + o)); __builtin_nontemporal_store(bd0, (f32x4*)(so0 + 2048 + o));
      __builtin_nontemporal_store(dec1, (f32x4*)(so1 + o)); __builtin_nontemporal_store(kd1, (f32x4*)(so1 + 1024 + o)); __builtin_nontemporal_store(bd1, (f32x4*)(so1 + 2048 + o));
      __builtin_nontemporal_store(av, (f32x4*)(sh + o)); __builtin_nontemporal_store(rr, (f32x4*)(sh + 1024 + o)); __builtin_nontemporal_store(vv, (f32x4*)(sh + 2048 + o));
      { uint2 gw_; gw_.x = pk_bf16(ag[0], ag[1]); gw_.y = pk_bf16(ag[2], ag[3]); *(uint2*)(gbp + o) = gw_; }
#pragma unroll
      for (int ks = 0; ks < 12; ++ks) wcur[ks] = wnx[ks];
    }
    sd += __shfl_xor(sd, 16); sd += __shfl_xor(sd, 32);
    if (fq == 0) p.BON[(size_t)row * 12 + h] = sd;
  }
  __syncthreads();
}

template <bool SOFT>
__device__ void pool_task(const P& p, int layer, int task, char* lds, HalfBar& hb) {
  float* raw = (float*)lds;
  bf16_t* mmb = (bf16_t*)(raw + 48 * 128);
  const int tid = otid();
  const int gi = task & 3, row0 = (task >> 2) * 32;
  int s0, s1; seq_bounds(row0, s0, s1);
  const int w = 2 << gi, half = w >> 1;
#pragma unroll 8
  for (int i = 0; i < 24; ++i) {
    int idx = tid + NT * i; int pp = idx >> 7, ch = idx & 127;
    int row = row0 - 8 + pp;
    raw[idx] = (row >= s0 && row < s1) ? p.Z[zidx(row, 2688 + gi * 128 + ch)] : 0.f;
  }
  vbar<SOFT>(hb);
  for (int i = 0; i < 16; ++i) {
    int idx = tid + NT * i; int tok = idx >> 7, ch = idx & 127;
    int row = row0 + tok;
    int lo = max(row - half, s0), hi = min(row + half, s1);
    float sum = 0.f;
    for (int r = lo; r < hi; ++r) sum += raw[(r - row0 + 8) * 128 + ch];
    mmb[tok * 136 + ch] = f2bf(sum * __builtin_amdgcn_rcpf((float)(hi - lo)) - raw[(tok + 8) * 128 + ch]);
  }
  vbar<SOFT>(hb);
  const int lane = tid & 63, wave = tid >> 6, fr = lane & 15, fq = lane >> 4;
  const bf16_t* pf = p.PWF + (size_t)(layer * 4 + gi) * (8 * 4 * 64 * 8);
#pragma unroll
  for (int qq = 0; qq < 2; ++qq) {
    const int nt = wave * 2 + qq;
    f32x4 acc0 = {0.f, 0.f, 0.f, 0.f}, acc1 = acc0;
#pragma unroll
    for (int ks = 0; ks < 4; ++ks) {
      const bf16x8 wf = *(const bf16x8*)(pf + ((size_t)(nt * 4 + ks) * 64 + lane) * 8);
      const bf16x8 m0 = *(const bf16x8*)(mmb + fr * 136 + ks * 32 + fq * 8), m1 = *(const bf16x8*)(mmb + (16 + fr) * 136 + ks * 32 + fq * 8);
      acc0 = __builtin_amdgcn_mfma_f32_16x16x32_bf16(wf, m0, acc0, 0, 0, 0);
      acc1 = __builtin_amdgcn_mfma_f32_16x16x32_bf16(wf, m1, acc1, 0, 0, 0);
    }
    const int d0 = nt * 16 + fq * 4;
    const f32x4 sc = *(const f32x4*)(p.pool_scale + layer * 512 + gi * 128 + d0);
    uint2 w;
    w.x = pk_bf16(acc0[0] * sc[0], acc0[1] * sc[1]); w.y = pk_bf16(acc0[2] * sc[2], acc0[3] * sc[3]);
    *(uint2*)(p.HB + (size_t)(row0 + fr) * D + DR + gi * 128 + d0) = w;
    w.x = pk_bf16(acc1[0] * sc[0], acc1[1] * sc[1]); w.y = pk_bf16(acc1[2] * sc[2], acc1[3] * sc[3]);
    *(uint2*)(p.HB + (size_t)(row0 + 16 + fr) * D + DR + gi * 128 + d0) = w;
  }
  vbar<SOFT>(hb);
}

__device__ void attn_wave_task(const P& p, int layer, int wt) {
  const int lane = otid() & 63, fr = lane & 15, fq = lane >> 4;
  int b, qh, t0, qrow0; bool lat;
  if (wt < 6144) { lat = true; b = wt / 3072; int r = wt % 3072; const int hk_ = r / 768; r %= 768; qh = hk_ * 3 + r % 3; t0 = (r / 3) * 16; qrow0 = b * T + t0; }
  else { lat = false; int r = wt - 6144; b = r / 192; r %= 192; const int hk_ = r / 48; r %= 48; qh = hk_ * 3 + r % 3; t0 = (r / 3) * 16; qrow0 = NLAT + b * CTX + t0; }
  const int hk = qh / 3;
  bf16x8 qf[2];
  qf[0] = *(const bf16x8*)(p.QB + (size_t)(qrow0 + fr) * DR + qh * 64 + fq * 8);
  qf[1] = *(const bf16x8*)(p.QB + (size_t)(qrow0 + fr) * DR + qh * 64 + 32 + fq * 8);
  float m_run = -1e30f, l_run = 0.f;
  f32x4 o[4];
#pragma unroll
  for (int i = 0; i < 4; ++i) o[i] = (f32x4){0.f, 0.f, 0.f, 0.f};
  const int qpos = t0 + fr;
  int nwin = 0, kw0 = 0;
  if (lat) { kw0 = max(t0 - 128, 0) & ~31; int kend = min(T, t0 + 16 + 128); nwin = (kend - kw0 + 31) >> 5; }
  const int ntile = nwin + 8;
  const bf16_t* vbase = p.VT + (size_t)(b * 4 + hk) * 64 * VTS;
  const int kperm = 8 * (fr >> 2) + (fr & 3);
#define ATT_LOAD(it_, K00, K01, K10, K11, V0, V1, V2, V3) { \
    const int tile_ = (it_) < nwin ? ((kw0 >> 5) + (it_)) : 128 + ((it_) - nwin); \
    const size_t tb_ = ((size_t)((b * 4 + hk) * 136 + tile_) * 4 * 64 + lane) * 8; \
    const bf16_t* kp_ = p.KB + tb_; \
    K00 = *(const bf16x8*)(kp_); K01 = *(const bf16x8*)(kp_ + 512); K10 = *(const bf16x8*)(kp_ + 1024); K11 = *(const bf16x8*)(kp_ + 1536); \
    const bf16_t* vp_ = p.VT + tb_; \
    V0 = *(const bf16x8*)(vp_); V1 = *(const bf16x8*)(vp_ + 512); V2 = *(const bf16x8*)(vp_ + 1024); V3 = *(const bf16x8*)(vp_ + 1536); }
  bf16x8 k00, k01, k10, k11, v0, v1, v2, v3;
  ATT_LOAD(0, k00, k01, k10, k11, v0, v1, v2, v3)
  for (int it = 0; it < ntile; ++it) {
    const bool win = it < nwin;
    const int kpos0 = kw0 + it * 32;
    bf16x8 n00, n01, n10, n11, nv0, nv1, nv2, nv3;
    { const int itn = min(it + 1, ntile - 1); ATT_LOAD(itn, n00, n01, n10, n11, nv0, nv1, nv2, nv3) }
    asm volatile("" ::: "memory");
    f32x4 s[2];
    s[0] = (f32x4){0.f, 0.f, 0.f, 0.f}; s[1] = s[0];
    s[0] = __builtin_amdgcn_mfma_f32_16x16x32_bf16(k00, qf[0], s[0], 0, 0, 0);
    s[1] = __builtin_amdgcn_mfma_f32_16x16x32_bf16(k10, qf[0], s[1], 0, 0, 0);
    s[0] = __builtin_amdgcn_mfma_f32_16x16x32_bf16(k01, qf[1], s[0], 0, 0, 0);
    s[1] = __builtin_amdgcn_mfma_f32_16x16x32_bf16(k11, qf[1], s[1], 0, 0, 0);
    float mloc = -1e30f;
    bool valid[2][4];
#pragma unroll
    for (int kk = 0; kk < 2; ++kk)
#pragma unroll
      for (int r = 0; r < 4; ++r) {
        bool v = true;
        if (win) { int kpos = kpos0 + 8 * fq + 4 * kk + r; int dlt = kpos - qpos; v = (dlt <= 128) && (dlt >= -128); }
        valid[kk][r] = v;
        if (v) mloc = fmaxf(mloc, s[kk][r]);
      }
    mloc = fmaxf(mloc, __shfl_xor(mloc, 16));
    mloc = fmaxf(mloc, __shfl_xor(mloc, 32));
    const float m_new = fmaxf(m_run, mloc);
    const float alpha = __expf(m_run - m_new);
    float pv[8]; float ps = 0.f;
#pragma unroll
    for (int kk = 0; kk < 2; ++kk)
#pragma unroll
      for (int r = 0; r < 4; ++r) { float e = valid[kk][r] ? __expf(s[kk][r] - m_new) : 0.f; pv[kk * 4 + r] = e; ps += e; }
    l_run = l_run * alpha + ps;
    m_run = m_new;
    union { bf16x8 v; unsigned u[4]; } pf;
    pf.u[0] = pk_bf16(pv[0], pv[1]); pf.u[1] = pk_bf16(pv[2], pv[3]); pf.u[2] = pk_bf16(pv[4], pv[5]); pf.u[3] = pk_bf16(pv[6], pv[7]);
    o[0] = o[0] * alpha; o[1] = o[1] * alpha; o[2] = o[2] * alpha; o[3] = o[3] * alpha;
    o[0] = __builtin_amdgcn_mfma_f32_16x16x32_bf16(v0, pf.v, o[0], 0, 0, 0);
    o[1] = __builtin_amdgcn_mfma_f32_16x16x32_bf16(v1, pf.v, o[1], 0, 0, 0);
    o[2] = __builtin_amdgcn_mfma_f32_16x16x32_bf16(v2, pf.v, o[2], 0, 0, 0);
    o[3] = __builtin_amdgcn_mfma_f32_16x16x32_bf16(v3, pf.v, o[3], 0, 0, 0);
    k00 = n00; k01 = n01; k10 = n10; k11 = n11; v0 = nv0; v1 = nv1; v2 = nv2; v3 = nv3;
  }
#undef ATT_LOAD
  l_run += __shfl_xor(l_run, 16);
  l_run += __shfl_xor(l_run, 32);
  l_run += __expf(p.sink[layer * 12 + qh] - m_run);
  const float inv = 1.f / l_run;
#pragma unroll
  for (int dt = 0; dt < 4; ++dt) {
    uint2 w; w.x = pk_bf16(o[dt][0] * inv, o[dt][1] * inv); w.y = pk_bf16(o[dt][2] * inv, o[dt][3] * inv);
    *(uint2*)(p.HB + (size_t)(qrow0 + fr) * D + 1280 + qh * 64 + dt * 16 + fq * 4) = w;
  }
}

__device__ void mix_phase(const P& p, int layer, char* lds) {
  const int ntask = NTOK / 16, nfull = min(ntask, VG);
  UNIFORM_TASKS(t, nfull, obid(), VG, 2, prep_task(p, layer, t, 0, 3, lds))
  UNIFORM_TASKS(it, (ntask - nfull) * 3, obid(), VG, 2, prep_task(p, layer, nfull + it / 3, it % 3, it % 3 + 1, lds))
}

__device__ void convert_rest(const P& p, int layer, int ob, int nb, char* lds, HalfBar& hb) {
  float* s = (float*)lds;
  constexpr int T_IN = 32 * 70, T_OUT = 32 * 32, T_GU = 32 * 176, T_DN = 88 * 32, T_L = T_IN + T_OUT + T_GU + T_DN;
  const int beg = layer == 0 ? T_IN : T_L + T_IN, end = layer == 0 ? T_L + T_IN : 2 * T_L;
  for (int it = beg + ob; it < end; it += nb) {
    int l = it / T_L, t = it % T_L;
    if (t < T_IN) convert_tile<true>(p.w_in + (size_t)l * D * DIN, D, DIN, p.wt_in + (size_t)l * DINP * D, 0, t, s, hb);
    else if (t < T_IN + T_OUT) convert_tile<true>(p.w_out + (size_t)l * D * D, D, D, p.wt_out + (size_t)l * D * D, 0, t - T_IN, s, hb);
    else if (t < T_IN + T_OUT + T_GU) convert_tile<true>(p.w_gu + (size_t)l * D * 2 * FH, D, 2 * FH, p.wt_gu + (size_t)l * 2 * FH * D, 1, t - T_IN - T_OUT, s, hb);
    else convert_tile<true>(p.w_down + (size_t)l * FH * D, FH, D, p.wt_down + (size_t)l * D * FH, 0, t - T_IN - T_OUT - T_GU, s, hb);
  }
}

typedef float f32x2 __attribute__((ext_vector_type(2)));
__device__ void scan_phase(const P& p, int layer, char* lds, volatile __attribute__((address_space(3))) unsigned* hbw) {
  const int rb = rbid(), half = __builtin_amdgcn_readfirstlane(threadIdx.x >> 8);
  __syncthreads();
  if (otid() == 0) hbw[half * 4] = 0u;
  __syncthreads();
  HalfBar hb{hbw + half * 4, 0u};
  const bool scanner = rb < 192 && half == 0;
  const int bid = rb;
  if (!scanner) {
    const int nb = 192 + ((int)gridDim.x - 192) * 2, ob = rb < 192 ? rb : 192 + (rb - 192) * 2 + half;
    const int npool = (layer == 0 ? NTOK : NLAT) / 32 * 4;
    for (int t = ob; t < npool; t += nb) pool_task<true>(p, layer, t, lds, hb);
    const int nat = layer == 0 ? 6144 + 384 : 6144;
    for (int wt = ob * 4 + (otid() >> 6); wt < nat; wt += nb * 4) attn_wave_task(p, layer, wt);
    vbar<true>(hb);
    convert_rest(p, layer, ob, nb, lds, hb);
    return;
  }
  __builtin_amdgcn_s_setprio(3);
  const int tid = otid(), lane = tid & 63, wave = tid >> 6;
  const int chain = bid >> 2, rq = bid & 3;
  const int b = chain / 24, d = (chain / 12) & 1, h = chain % 12;
  const int rl = lane >> 4, q = lane & 15;
  const int ri = rq * 16 + wave * 4 + rl;
  const int sgn = d ? -1 : 1;
  constexpr int TC = 16, NCH = (CTX + T) / TC, RS = 12 * 192;
  float4* l4 = (float4*)lds;
#define ROWBASE(c) ((c) < CTX / TC ? NLAT + b * CTX + (d ? CTX - 1 - (c) * TC : (c) * TC) : b * T + (d ? T - 1 - ((c) - CTX / TC) * TC : ((c) - CTX / TC) * TC))
  const float *bp0, *bp1, *bp2, *bp3, *bp4, *bp5; int lo0, lo1, lo2, lo3, lo4, lo5;
#define SCAN_BP(BP, LO, i) { const int gi = tid + NT * (i); const int sh_ = gi >= 768 ? 1 : 0; const int g = gi - sh_ * 768; \
    const int vec = g >> 8, ct = (g >> 6) & 3, tk = (g >> 2) & 15, fq_ = g & 3; const int st = d ? 15 - tk : tk; \
    LO = st * 96 + sh_ * 48 + vec * 16 + ct * 4 + fq_; \
    BP = (sh_ ? p.SHR + (size_t)h * 3072 : p.SOPS + ((size_t)d * (NTOK / 16) * 12 + h) * 3072) + g * 4; }
  SCAN_BP(bp0, lo0, 0) SCAN_BP(bp1, lo1, 1) SCAN_BP(bp2, lo2, 2) SCAN_BP(bp3, lo3, 3) SCAN_BP(bp4, lo4, 4) SCAN_BP(bp5, lo5, 5)
  float* const ybp = p.YB + ((size_t)d * NTOK * DR + h * 64 + ri) + (ptrdiff_t)(sgn * q) * DR;
  float4 ra0, ra1, ra2, ra3, ra4, ra5, rb0, rb1, rb2, rb3, rb4, rb5;
#define load_chunk(c, R) { const size_t ro = (size_t)((ROWBASE(c) - (d ? 15 : 0)) >> 4) * (12 * 3072); R##0 = *(const float4*)(bp0 + ro); R##1 = *(const float4*)(bp1 + ro); R##2 = *(const float4*)(bp2 + ro); \
    R##3 = *(const float4*)(bp3 + ro); R##4 = *(const float4*)(bp4 + ro); R##5 = *(const float4*)(bp5 + ro); }
#define store_chunk(buf, R) { float4* lp = l4 + (buf) * (TC * 96); lp[lo0] = R##0; lp[lo1] = R##1; lp[lo2] = R##2; lp[lo3] = R##3; lp[lo4] = R##4; lp[lo5] = R##5; }
#define LDSTEP(sp, W, K, B, A, R, V) { W = *(const f32x4*)((sp) + 4 * q); K = *(const f32x4*)((sp) + 64 + 4 * q); B = *(const f32x4*)((sp) + 128 + 4 * q); \
    A = *(const f32x4*)((sp) + 192 + 4 * q); R = *(const f32x4*)((sp) + 256 + 4 * q); V = (sp)[320 + ri]; }
#define SCAN_CHUNK(c, cur) { \
    const float* base = (const float*)lds + (cur) * (TC * 384); \
    f32x4 w4, k4, b4, a4, r4; float v; \
    LDSTEP(base, w4, k4, b4, a4, r4, v) \
    float ykeep = 0.f; \
    _Pragma("unroll") \
    for (int st = 0; st < TC; ++st) { \
      f32x4 nw, nk, nb, na, nr; float nv; \
      if (st + 1 < TC) LDSTEP(base + (st + 1) * 384, nw, nk, nb, na, nr, nv) \
      f32x2 pa = S01 * a4.lo; \
      pa = S23 * a4.hi + pa; \
      const f32x2 t01 = S01 * w4.lo + k4.lo * v, t23 = S23 * w4.hi + k4.hi * v; \
      const float sa = reduce16(pa.x + pa.y); \
      S01 = b4.lo * sa + t01; \
      S23 = b4.hi * sa + t23; \
      f32x2 py = S01 * r4.lo; \
      py = S23 * r4.hi + py; \
      const float y = reduce16(py.x + py.y); \
      ykeep = (q == st) ? y : ykeep; \
      if (st + 1 < TC) { w4 = nw; k4 = nk; b4 = nb; a4 = na; r4 = nr; v = nv; } \
    } \
    ybp[(size_t)(ROWBASE(c)) * DR] = ykeep; }
  f32x2 S01 = {0.f, 0.f}, S23 = {0.f, 0.f};
  load_chunk(0, ra); store_chunk(0, ra); load_chunk(1, ra); load_chunk(2, rb);
  vbar<true>(hb);
  for (int c = 0; c < NCH; c += 2) {
    SCAN_CHUNK(c, 0)
    store_chunk(1, ra);
    if (c + 3 < NCH) load_chunk(c + 3, ra);
    vbar<true>(hb);
    SCAN_CHUNK(c + 1, 1)
    if (c + 2 < NCH) store_chunk(0, rb);
    if (c + 4 < NCH) load_chunk(c + 4, rb);
    vbar<true>(hb);
  }
#undef SCAN_CHUNK
  __builtin_amdgcn_s_setprio(0);
#undef ROWBASE
#undef SCAN_BP
#undef LDSTEP
#undef load_chunk
#undef store_chunk
}

__device__ void readout_phase(const P& p, int layer, int nrows) {
  const int tid = otid();
  for (int row = obid(); row < nrows; row += VG) {
#pragma unroll
    for (int j = 0; j < 3; ++j) {
      const int c = tid + NT * j;
      float y = p.YB[(size_t)row * DR + c] + p.YB[((size_t)NTOK + row) * DR + c];
      float mu = wave_sum(y) * (1.f / 64.f);
      float dlt = y - mu;
      float var = wave_sum(dlt * dlt) * (1.f / 64.f);
      float yn = dlt * rsqrtf(var + 64e-5f) * p.ln_g[layer * DR + c] + p.ln_b[layer * DR + c];
      const size_t gi = (((size_t)(row >> 4) * 12 + (c >> 6)) * 4 + ((c >> 4) & 3)) * 256 + (row & 15) * 16 + (c & 15);
      const size_t vi = ((size_t)(row >> 4) * 12 + (c >> 6)) * 3072 + 2048 + ((c >> 4) & 3) * 256 + (row & 15) * 16 + (c & 15);
      float o = (yn + p.SHR[vi] * p.BON[(size_t)row * 12 + (c >> 6)]) * __uint_as_float((unsigned)((const bf16_t*)p.GB)[gi] << 16);
      p.HB[(size_t)row * D + c] = f2bf(o);
    }
  }
}

#define XB_TMO      128
#define XB_XCNT(j)  (256  + 64 * (j))
#define XB_XSUB(j)  (1280 + 64 * (j))
#define XB_XGEN(j)  (2304 + 64 * (j))
#define XB_TOP      3328
#define XB_TOPGEN   3392
#define XCD_BAR_WORDS 3456
#define XB_SPIN_CAP (1u << 22)
#define LAS __attribute__((address_space(3)))
__device__ __forceinline__ unsigned xb_ld(unsigned* p)              { return __hip_atomic_load(p, __ATOMIC_RELAXED, __HIP_MEMORY_SCOPE_AGENT); }
__device__ __forceinline__ unsigned xb_add(unsigned* p, unsigned v) { return __hip_atomic_fetch_add(p, v, __ATOMIC_RELAXED, __HIP_MEMORY_SCOPE_AGENT); }
__device__ __forceinline__ unsigned xb_xcc_id() { return (unsigned)__builtin_amdgcn_s_getreg((3 << 11) | 20) & 0xFu; }
#define XB_SPIN(cond, bar) do { unsigned _sp = 0; while (cond) { __builtin_amdgcn_s_sleep(1); \
    if ((++_sp & 255u) == 0u) { if (xb_ld(&(bar)[XB_TMO])) break; if (_sp > XB_SPIN_CAP) { atomicAdd(&(bar)[XB_TMO], 1u); break; } } } } while (0)
struct XcdBarrier { unsigned* bar; unsigned x; volatile LAS unsigned* st; };
__device__ __forceinline__ XcdBarrier xcd_barrier_post(unsigned* bar, volatile LAS unsigned* st) {
  XcdBarrier b; b.bar = bar; b.x = xb_xcc_id(); b.st = st;
  if (threadIdx.x == 0) (void)xb_add(&bar[XB_XCNT(b.x)], 1u);
  return b;
}
__device__ __forceinline__ void xcd_barrier_complete(unsigned* bar, unsigned x, unsigned& nloc, unsigned& nx) {
  const unsigned G = gridDim.x * gridDim.y * gridDim.z;
  unsigned sum, cnt, mine, sp = 0u;
  for (;;) {
    sum = 0u; cnt = 0u; mine = 0u;
#pragma unroll
    for (unsigned j = 0; j < 16; ++j) { const unsigned c = xb_ld(&bar[XB_XCNT(j)]); sum += c; cnt += (c > 0u) ? 1u : 0u; mine = (j == x) ? c : mine; }
    if (sum == G) break;
    __builtin_amdgcn_s_sleep(1);
    if ((++sp & 255u) == 0u) { if (xb_ld(&bar[XB_TMO])) break; if (sp > XB_SPIN_CAP) { atomicAdd(&bar[XB_TMO], 1u); break; } }
  }
  nloc = mine > 0u ? mine : 1u; nx = cnt > 0u ? cnt : 1u;
}
__device__ __forceinline__ void xcd_barrier(const XcdBarrier& b) {
  asm volatile("s_waitcnt vmcnt(0)" ::: "memory");
  __syncthreads();
  if (threadIdx.x == 0) {
    unsigned* bar = b.bar;
    __builtin_amdgcn_s_waitcnt(0);
    unsigned nloc = b.st[0], nx = b.st[1];
    if (nloc == 0u) { xcd_barrier_complete(bar, b.x, nloc, nx); b.st[0] = nloc; b.st[1] = nx; }
    const unsigned old = xb_add(&bar[XB_XSUB(b.x)], 1u);
    const unsigned gen = old / nloc;
    if (old + 1u == (gen + 1u) * nloc) {
      __builtin_amdgcn_fence(__ATOMIC_RELEASE, "agent");
      asm volatile("s_waitcnt vmcnt(0)" ::: "memory");
      const unsigned og = xb_add(&bar[XB_TOP], 1u);
      const unsigned tg = og / nx;
      if (og + 1u == (tg + 1u) * nx) xb_add(&bar[XB_TOPGEN], 1u);
      else XB_SPIN(xb_ld(&bar[XB_TOPGEN]) == tg, bar);
      __builtin_amdgcn_fence(__ATOMIC_ACQUIRE, "agent");
      xb_add(&bar[XB_XGEN(b.x)], 1u);
      asm volatile("s_waitcnt vmcnt(0)" ::: "memory");
    } else {
      XB_SPIN(xb_ld(&bar[XB_XGEN(b.x)]) == gen, bar);
      __builtin_amdgcn_fence(__ATOMIC_ACQUIRE, "agent");
      asm volatile("s_waitcnt vmcnt(0)" ::: "memory");
    }
  }
  __syncthreads();
}

__global__ void __launch_bounds__(NTR, 2) fwd_megakernel(P p) {
  extern __shared__ __attribute__((aligned(16))) char lds[];
  cg::grid_group grid = cg::this_grid();
  volatile LAS unsigned* st = (volatile LAS unsigned*)(lds + 131072);
#define ldsh (lds + (rtid() >> 8) * 65536)
  if (threadIdx.x < 4) st[threadIdx.x] = 0u;
  __syncthreads();
  (void)xcd_barrier_post(p.bar, st);
  if (gridDim.x == 0x7fffffffu) grid.sync();
#define GSYNC() do { XcdBarrier b_; b_.bar = p.bar; b_.x = xb_xcc_id(); b_.st = (volatile LAS unsigned*)(lds + 131072); xcd_barrier(b_); } while (0)
  phase_a(p, ldsh);
  GSYNC();
  phase_b(p);
  GSYNC();
#pragma unroll 1
  for (int l = 0; l < 2; ++l) {
    const int M2 = l == 0 ? NTOK : NLAT;
    norm_phase(p, l, 0, NTOK);
    GSYNC();
    gemm_phase<EPI_IN>(p, l, p.HB, p.wt_in + (size_t)l * DINP * D, NTOK, DINP, D, lds);
    GSYNC();
    mix_phase(p, l, ldsh);
    GSYNC();
    scan_phase(p, l, ldsh, (volatile LAS unsigned*)(lds + 131072) + 8);
    GSYNC();
    readout_phase(p, l, M2);
    GSYNC();
    gemm_phase<EPI_OUT>(p, l, p.HB, p.wt_out + (size_t)l * D * D, M2, D, D, lds, NLAT, 8, p.Z);
    GSYNC();
    norm_phase(p, l, 1, M2);
    GSYNC();
    gemm_phase<EPI_GU>(p, l, p.HB, p.wt_gu + (size_t)l * 2 * FH * D, M2, 2 * FH, D, lds);
    GSYNC();
    gemm_phase<EPI_DOWN>(p, l, p.HID, p.wt_down + (size_t)l * D * FH, M2, D, FH, lds, NLAT, 11, p.Z + (size_t)8 * NCTXR * D);
    GSYNC();
  }
  final_phase(p);
}

extern "C" void kernel_launch(void* const* d_in, const int* in_sizes, int n_in, void* d_out, int out_size, void* d_ws, size_t ws_size,
                              hipStream_t stream) {
  static int grid_blocks = 0;
  if (!grid_blocks) {
    int dev = 0, cus = 0, per_cu = 0;
    hipGetDevice(&dev);
    hipDeviceGetAttribute(&cus, hipDeviceAttributeMultiprocessorCount, dev);
    hipFuncSetAttribute((const void*)fwd_megakernel, hipFuncAttributeMaxDynamicSharedMemorySize, LDS_BYTES);
    hipOccupancyMaxActiveBlocksPerMultiprocessor(&per_cu, fwd_megakernel, NTR, LDS_BYTES);
    if (per_cu > 1) per_cu = 1;
    if (per_cu < 1) per_cu = 1;
    grid_blocks = cus * per_cu;
  }
  P p{};
  const float* const* in = (const float* const*)d_in;
  p.x = in[0]; p.c = in[1]; p.ctx = in[2]; p.c_ctx = in[3]; p.ada_w = in[4]; p.ada_b = in[5]; p.nmg = in[6]; p.nfg = in[7]; p.w_in = in[8];
  p.mu = in[9]; p.w0 = in[10]; p.w_up = in[11]; p.a0 = in[12]; p.a_up = in[13]; p.g_up = in[14]; p.k_k = in[15]; p.k_a = in[16]; p.r_k = in[17];
  p.ln_g = in[18]; p.ln_b = in[19]; p.pool_w = in[20]; p.pool_scale = in[21]; p.sink = in[22]; p.w_out = in[23]; p.w_gu = in[24]; p.w_down = in[25];
  p.fng = in[26];
  p.out = (float*)d_out;
  char* w = (char*)d_ws; size_t off = 0;
  auto take = [&](size_t bytes) { char* r = w + off; off += (bytes + 255) & ~(size_t)255; return r; };
  p.wt_in = (bf16_t*)take((size_t)2 * DINP * D * 2);
  p.wt_out = (bf16_t*)take((size_t)2 * D * D * 2);
  p.wt_gu = (bf16_t*)take((size_t)2 * 2 * FH * D * 2);
  p.wt_down = (bf16_t*)take((size_t)2 * D * FH * 2);
  p.X = (float*)take((size_t)NTOK * D * 4);
  p.HB = (bf16_t*)take((size_t)NTOK * D * 2);
  p.Z = (float*)take((size_t)NTOK * ZC * 4);
  p.QB = (bf16_t*)take((size_t)NTOK * DR * 2);
  p.KB = (bf16_t*)take((size_t)NTOK * 256 * 2);
  p.VT = (bf16_t*)take((size_t)2 * 4 * 64 * VTS * 2);
  p.SOPS = (float*)take((size_t)2 * NTOK * 12 * 192 * 4);
  p.SHR = (float*)take((size_t)NTOK * 12 * 192 * 4);
  p.GB = (float*)take((size_t)NTOK * DR * 4);
  p.BON = (float*)take((size_t)NTOK * DR * 4);
  p.YB = (float*)take((size_t)2 * NTOK * DR * 4);
  p.MOD = (float*)take((size_t)2 * 3 * 6 * D * 4);
  p.ROPE = (float*)take(2048 * 4);
  p.bar = (unsigned*)take(XCD_BAR_WORDS * 4);
  p.WLR = (bf16_t*)take((size_t)2 * DR * 384 * 2);
  p.PWF = (bf16_t*)take((size_t)2 * 4 * 128 * 128 * 2);
  p.HID = (bf16_t*)p.SOPS;
  p.MODP = p.SOPS;
  if (off > ws_size) { fprintf(stderr, "workspace too small: need %zu have %zu\n", off, ws_size); return; }
  hipMemsetAsync(p.bar, 0, XCD_BAR_WORDS * 4, stream);
  void* args[] = {&p};
  hipError_t e = hipLaunchCooperativeKernel((const void*)fwd_megakernel, dim3(grid_blocks), dim3(NTR), args, LDS_BYTES, stream);
  if (e != hipSuccess) fprintf(stderr, "cooperative launch failed: %s (grid %d)\n", hipGetErrorString(e), grid_blocks);
}
```
